# Optimizing an MI355X kernel written in HIP

```python
import math
import jax, jax.numpy as jnp
from jax import lax
import numpy as np

D_MODEL = 2048
BATCH = 2
SEQ = 4096
DEPTH = 1
DEC_BATCH = 4
DEC_SEQ = 2048
PAST_LEN = 128

HEAD_DIM = 128
MIX_WIDTH = D_MODEL
N_ATTN_HEADS = 8
N_KV_HEADS = 2
GQA_GROUP = N_ATTN_HEADS // N_KV_HEADS
ATTN_WIDTH = N_ATTN_HEADS * HEAD_DIM
KV_WIDTH = N_KV_HEADS * HEAD_DIM
N_GMLP_HEADS = 8
GMLP_WIDTH = N_GMLP_HEADS * HEAD_DIM
IN_WIDTH = ATTN_WIDTH + 2 * KV_WIDTH + 2 * GMLP_WIDTH
WINDOW = 128
BLOCK = 128
CHUNK = 128
ROPE_THETA = 500000.0
ROT_DIM = HEAD_DIM // 4
D_FF = 4 * D_MODEL
EPS = 1e-6
NEG_INF = -1e30

kernel_name = "hymba_style_window_gqa_gmlp_encoder"


def rms_norm(x, g):
    xf = x.astype(jnp.float32)
    y = xf * lax.rsqrt(jnp.mean(xf * xf, axis=-1, keepdims=True) + EPS)
    return (y * g.astype(jnp.float32)).astype(x.dtype)


def layer_norm(x, g, b):
    xf = x.astype(jnp.float32)
    mu = jnp.mean(xf, axis=-1, keepdims=True)
    xc = xf - mu
    y = xc * lax.rsqrt(jnp.mean(xc * xc, axis=-1, keepdims=True) + EPS)
    return (y * g.astype(jnp.float32) + b.astype(jnp.float32)).astype(x.dtype)


def partial_rope(x):
    S = x.shape[1]
    pos = jnp.arange(S, dtype=jnp.float32)
    inv_freq = ROPE_THETA ** (-jnp.arange(0, ROT_DIM, 2, dtype=jnp.float32) / ROT_DIM)
    ang = pos[:, None] * inv_freq[None, :]
    cos = jnp.cos(ang)[None, :, None, :]
    sin = jnp.sin(ang)[None, :, None, :]
    xf = x.astype(jnp.float32)
    half = ROT_DIM // 2
    x1 = xf[..., :half]
    x2 = xf[..., half:ROT_DIM]
    out = jnp.concatenate([x1 * cos - x2 * sin, x2 * cos + x1 * sin, xf[..., ROT_DIM:]], axis=-1)
    return out.astype(x.dtype)


def windowed_gqa_sink(q, k, v, sink):
    B, S = q.shape[0], q.shape[1]
    nb = S // BLOCK
    qb = q.reshape(B, nb, BLOCK, N_KV_HEADS, GQA_GROUP, HEAD_DIM)
    pad = ((0, 0), (BLOCK, BLOCK), (0, 0), (0, 0))
    kp = jnp.pad(k, pad).reshape(B, nb + 2, BLOCK, N_KV_HEADS, HEAD_DIM)
    vp = jnp.pad(v, pad).reshape(B, nb + 2, BLOCK, N_KV_HEADS, HEAD_DIM)
    kwin = jnp.concatenate([kp[:, :-2], kp[:, 1:-1], kp[:, 2:]], axis=2)
    vwin = jnp.concatenate([vp[:, :-2], vp[:, 1:-1], vp[:, 2:]], axis=2)
    scale = 1.0 / math.sqrt(HEAD_DIM)
    s = jnp.einsum('bnqkgd,bnmkd->bnkgqm', qb, kwin,
                   preferred_element_type=jnp.float32) * scale
    blk = jnp.arange(nb)[:, None]
    qpos = blk * BLOCK + jnp.arange(BLOCK)[None, :]
    kpos = (blk - 1) * BLOCK + jnp.arange(3 * BLOCK)[None, :]
    valid = ((jnp.abs(qpos[:, :, None] - kpos[:, None, :]) <= WINDOW)
             & (kpos >= 0)[:, None, :] & (kpos < S)[:, None, :])
    s = jnp.where(valid[None, :, None, None], s, NEG_INF)
    sink_l = sink.astype(jnp.float32).reshape(N_KV_HEADS, GQA_GROUP)[None, None, :, :, None, None]
    m = jnp.maximum(jnp.max(s, axis=-1, keepdims=True), sink_l)
    p = jnp.exp(s - m)
    p = p / (jnp.sum(p, axis=-1, keepdims=True) + jnp.exp(sink_l - m))
    o = jnp.einsum('bnkgqm,bnmkd->bnqkgd', p.astype(v.dtype), vwin)
    return o.reshape(B, S, ATTN_WIDTH)


def chunked_gmlp(u, vg, g_ln, b_ln, w_sp, b_sp):
    B, S = u.shape[0], u.shape[1]
    nc = S // CHUNK
    u = jax.nn.gelu(u)
    vg = layer_norm(jax.nn.gelu(vg), g_ln, b_ln)
    vc = vg.reshape(B, nc, CHUNK, N_GMLP_HEADS, HEAD_DIM)
    mixed = jnp.einsum('hij,bnjhc->bnihc', w_sp, vc) + b_sp.T[None, None, :, :, None]
    return u * mixed.reshape(B, S, GMLP_WIDTH)


def encoder_layer(x, g_mix, w_in, g_q, g_k, sink, g_v_ln, b_v_ln, w_spatial, b_spatial,
                  g_attn_out, g_gmlp_out, w_out, g_ffn, w_up, w_down):
    B, S, _ = x.shape
    h = rms_norm(x, g_mix)
    proj = h @ w_in
    o1 = ATTN_WIDTH
    o2 = o1 + KV_WIDTH
    o3 = o2 + KV_WIDTH
    o4 = o3 + GMLP_WIDTH
    q = proj[..., :o1].reshape(B, S, N_ATTN_HEADS, HEAD_DIM)
    k = proj[..., o1:o2].reshape(B, S, N_KV_HEADS, HEAD_DIM)
    v = proj[..., o2:o3].reshape(B, S, N_KV_HEADS, HEAD_DIM)
    u = proj[..., o3:o4]
    vg = proj[..., o4:]
    q = partial_rope(rms_norm(q, g_q))
    k = partial_rope(rms_norm(k, g_k))
    attn = windowed_gqa_sink(q, k, v, sink)
    gm = chunked_gmlp(u, vg, g_v_ln, b_v_ln, w_spatial, b_spatial)
    mix = jnp.concatenate([rms_norm(attn, g_attn_out), rms_norm(gm, g_gmlp_out)], axis=-1)
    x = x + mix @ w_out
    h2 = rms_norm(x, g_ffn)
    x = x + jnp.square(jax.nn.relu(h2 @ w_up)) @ w_down
    return x


def setup_inputs(seed: int = 0) -> dict:
    key = jax.random.key(seed)
    ks = jax.random.split(key, 20)
    f32 = jnp.float32
    nrm = lambda k, shape, s: jax.random.normal(k, shape, f32) * s
    L = DEPTH
    return {
        "x_prompt": jax.random.normal(ks[0], (BATCH, SEQ, D_MODEL), f32),
        "x_sample": jax.random.normal(ks[1], (DEC_BATCH, DEC_SEQ, D_MODEL), f32),
        "g_mix": 1.0 + nrm(ks[2], (L, D_MODEL), 0.02),
        "w_in": nrm(ks[3], (L, D_MODEL, IN_WIDTH), D_MODEL ** -0.5),
        "g_q": 1.0 + nrm(ks[4], (L, HEAD_DIM), 0.02),
        "g_k": 1.0 + nrm(ks[5], (L, HEAD_DIM), 0.02),
        "sink": nrm(ks[6], (L, N_ATTN_HEADS), 0.5),
        "g_v_ln": 1.0 + nrm(ks[7], (L, GMLP_WIDTH), 0.02),
        "b_v_ln": nrm(ks[8], (L, GMLP_WIDTH), 0.02),
        "w_spatial": nrm(ks[9], (L, N_GMLP_HEADS, CHUNK, CHUNK), CHUNK ** -0.5),
        "b_spatial": 1.0 + nrm(ks[10], (L, N_GMLP_HEADS, CHUNK), 0.1),
        "g_attn_out": 1.0 + nrm(ks[11], (L, ATTN_WIDTH), 0.02),
        "g_gmlp_out": 1.0 + nrm(ks[12], (L, GMLP_WIDTH), 0.02),
        "w_out": nrm(ks[13], (L, MIX_WIDTH, D_MODEL), MIX_WIDTH ** -0.5),
        "g_ffn": 1.0 + nrm(ks[14], (L, D_MODEL), 0.02),
        "w_up": nrm(ks[15], (L, D_MODEL, D_FF), D_MODEL ** -0.5),
        "w_down": nrm(ks[16], (L, D_FF, D_MODEL), D_FF ** -0.5),
    }


def reference(x_prompt, x_sample, g_mix, w_in, g_q, g_k, sink, g_v_ln, b_v_ln, w_spatial,
              b_spatial, g_attn_out, g_gmlp_out, w_out, g_ffn, w_up, w_down):
    y_prompt = x_prompt
    y_sample = x_sample
    for l in range(DEPTH):
        params = (g_mix[l], w_in[l], g_q[l], g_k[l], sink[l], g_v_ln[l], b_v_ln[l],
                  w_spatial[l], b_spatial[l], g_attn_out[l], g_gmlp_out[l], w_out[l],
                  g_ffn[l], w_up[l], w_down[l])
        y_prompt = encoder_layer(y_prompt, *params)
        y_sample = encoder_layer(y_sample, *params)
    return (y_prompt, y_sample)
```

```cpp
#include <hip/hip_runtime.h>
#include <hip/hip_cooperative_groups.h>
#include <cstdio>
#include <cstdint>
namespace cg = cooperative_groups;
namespace pg8 {
#define PG8_LAS __attribute__((address_space(3)))
typedef unsigned short bf16_t;
typedef short bf16x8 __attribute__((ext_vector_type(8)));
typedef float f32x4 __attribute__((ext_vector_type(4)));
typedef unsigned u32x4 __attribute__((ext_vector_type(4)));
constexpr int BM = 256, BK = 64, HALF = 128, HTB = HALF * BK * 2  , STAGE_BYTES = 8 * HTB, NXCD = 8, WGM = 8;

__host__ __device__ __forceinline__ int lds_byte(int r, int c) { const int st = (r >> 4) * 2 + (c >> 5), rr = r & 15, cc = c & 31, ob = rr * 64 + cc * 2; return st * 1024 + (ob ^ (((ob >> 9) & 1) << 5)); }
__host__ __device__ __forceinline__ void stage_rc(int b, int& R, int& C) { const int st = b / 1024, sb = b % 1024, swz = sb ^ (((sb >> 9) & 1) << 5); R = (st >> 1) * 16 + swz / 64; C = (st & 1) * 32 + (swz % 64) / 2; }
__host__ __device__ __forceinline__ int perm32(int rho) { const int n = rho >> 4, i = rho & 15; return 8 * (i >> 2) + 4 * n + (i & 3); }

struct Unit { int pm, pn, kh, slot; };
struct Gemm { const bf16_t* A; const bf16_t* Bt; int M, N, K, ld; };

struct StaticOrder {
    int nM, nN, nwg, G, c, wgm;
    __host__ __device__ void init(int M, int N, int G_, int c_, int wgm_ = WGM) { nM = M / BM; nN = N / BM; nwg = nM * nN; G = G_; c = c_; wgm = wgm_; }
    __host__ __device__ bool next(int i, Unit& u) const {
        const long L = (long)i * G + c; if (L >= nwg) return false;
        int wgid = (int)L; { const int q = nwg / NXCD, r = nwg % NXCD, xcd = wgid % NXCD, off = wgid / NXCD; wgid = (xcd < r ? xcd * (q + 1) : r * (q + 1) + (xcd - r) * q) + off; }
        const int nig = wgm * nN, gid = wgid / nig, fm = gid * wgm, gsz = (nM - fm) < wgm ? (nM - fm) : wgm;
        u.pm = fm + ((wgid % nig) % gsz); u.pn = (wgid % nig) / gsz; u.kh = 0; u.slot = i; return true;
    }
    __device__ __forceinline__ void a_ready(const Unit&) const {}
    __device__ __forceinline__ void done(const Unit&) const {}
};
__device__ __forceinline__ unsigned cvt_pk_bf16(float lo, float hi) { unsigned r; asm volatile("v_cvt_pk_bf16_f32 %0, %1, %2" : "=v"(r) : "v"(lo), "v"(hi)); return r; }
struct SplitOrder : StaticOrder {
    __host__ __device__ bool next(int i, Unit& u) const { if (!StaticOrder::next(i >> 1, u)) return false; u.kh = i & 1; u.slot = i >> 1; return true; }
};
typedef float f32x2 __attribute__((ext_vector_type(2)));
typedef unsigned u32x2 __attribute__((ext_vector_type(2)));
__device__ __forceinline__ float gelu_tanh(float x) {
    const float t = x * x * 0.044715f + 1.0f;
    const float e = __builtin_amdgcn_exp2f(x * t * (-2.0f * 0.7978845608028654f * 1.4426950408889634f));
    return x * __builtin_amdgcn_rcpf(1.0f + e);
}
constexpr int PROJ_LD = 3584, DM = 2048, DFF = 8192;
constexpr float EPSN = 1e-6f;

struct EpiProj {
    static constexpr bool PERM = true, AFTER_DRAIN = false, MID = false, MIDLOOP = false;
    bf16_t* O; const float* r1; float* lnstat; const float* gq; const float* gk; const float* tab; PG8_LAS float* xch;
    __device__ __forceinline__ void operator()(const f32x4 (&acc)[2][2][4][2], const Unit& u, int wr, int wc, int fr, int fq) const {
        const int row0 = u.pm * BM + wr * 64 + fr, col0 = u.pn * BM + wc * 32 + 8 * fq;
        if (u.pn <= 4) {
            float rsv[2][4];
#pragma unroll
            for (int ai = 0; ai < 2; ++ai)
#pragma unroll
                for (int m = 0; m < 4; ++m) {
                    const float rs = r1[row0 + ai * HALF + m * 16]; rsv[ai][m] = rs;
#pragma unroll
                    for (int bj = 0; bj < 2; ++bj) {
                        const f32x4 v0 = acc[ai][bj][m][0] * rs, v1 = acc[ai][bj][m][1] * rs;
                        float s = (v0[0] * v0[0] + v0[1] * v0[1]) + (v0[2] * v0[2] + v0[3] * v0[3]) + (v1[0] * v1[0] + v1[1] * v1[1]) + (v1[2] * v1[2] + v1[3] * v1[3]);
                        s += __shfl_xor(s, 16); s += __shfl_xor(s, 32);
                        if (fq == 0) xch[((((wr * 4 + wc) * 2 + ai) * 4 + m) * 2 + bj) * 16 + fr] = s;
                    }
                }
            asm volatile("s_waitcnt lgkmcnt(0)" ::: "memory"); __builtin_amdgcn_s_barrier(); asm volatile("" ::: "memory");
            const bool isq = u.pn < 4; const float* gp = (isq ? gq : gk) + wc * 32 + 8 * fq;
            const f32x4 g0 = *(const f32x4*)gp, g1 = *(const f32x4*)(gp + 4);
            const float osc = isq ? 0.08838834764831845f * 1.4426950408889634f : 1.0f;
#pragma unroll
            for (int ai = 0; ai < 2; ++ai)
#pragma unroll
                for (int m = 0; m < 4; ++m) {
                    const int row = row0 + ai * HALF + m * 16; const float rs = rsv[ai][m];
                    bf16_t* rowp = O + (size_t)row * PROJ_LD + col0;
                    f32x4 c0 = {0.f, 0.f, 0.f, 0.f}, c1 = c0, c2 = c0, c3 = c0;
                    if (wc == 0) { const int pos = (row < 8192) ? (row & 4095) : (row & 2047); const f32x4* tp = (const f32x4*)(tab + ((size_t)pos * 16 + 8 * (fq & 1)) * 2); c0 = tp[0]; c1 = tp[1]; c2 = tp[2]; c3 = tp[3]; }
#pragma unroll
                    for (int bj = 0; bj < 2; ++bj) {
                        float tot = 0.f;
#pragma unroll
                        for (int w = 0; w < 4; ++w) tot += xch[((((wr * 4 + w) * 2 + ai) * 4 + m) * 2 + bj) * 16 + fr];
                        const float sc = rs * __builtin_amdgcn_rsqf(tot * (1.0f / 128.0f) + EPSN);
                        f32x4 v0 = acc[ai][bj][m][0] * sc * g0, v1 = acc[ai][bj][m][1] * sc * g1;
                        if (wc == 0) {
                            f32x4 p0, p1;
#pragma unroll
                            for (int j = 0; j < 4; ++j) { p0[j] = __shfl_xor(v0[j], 32); p1[j] = __shfl_xor(v1[j], 32); }
                            const float sg = (fq < 2) ? -1.0f : 1.0f;
                            v0[0] = v0[0] * c0[0] + sg * p0[0] * c0[1]; v0[1] = v0[1] * c0[2] + sg * p0[1] * c0[3]; v0[2] = v0[2] * c1[0] + sg * p0[2] * c1[1]; v0[3] = v0[3] * c1[2] + sg * p0[3] * c1[3];
                            v1[0] = v1[0] * c2[0] + sg * p1[0] * c2[1]; v1[1] = v1[1] * c2[2] + sg * p1[1] * c2[3]; v1[2] = v1[2] * c3[0] + sg * p1[2] * c3[1]; v1[3] = v1[3] * c3[2] + sg * p1[3] * c3[3];
                        }
                        v0 *= osc; v1 *= osc;
                        u32x4 w; w.x = cvt_pk_bf16(v0[0], v0[1]); w.y = cvt_pk_bf16(v0[2], v0[3]); w.z = cvt_pk_bf16(v1[0], v1[1]); w.w = cvt_pk_bf16(v1[2], v1[3]);
                        __builtin_nontemporal_store(w, (u32x4*)(rowp + bj * HALF));
                    }
                }
            return;
        }
        const bool act = u.pn >= 6, st = u.pn >= 10;
#pragma unroll
        for (int ai = 0; ai < 2; ++ai)
#pragma unroll
            for (int m = 0; m < 4; ++m) {
                const int row = row0 + ai * HALF + m * 16; const float rs = r1[row];
                bf16_t* rowp = O + (size_t)row * PROJ_LD + col0; float s1 = 0.f, s2 = 0.f;
#pragma unroll
                for (int bj = 0; bj < 2; ++bj) {
                    f32x4 v0 = acc[ai][bj][m][0] * rs, v1 = acc[ai][bj][m][1] * rs;
                    if (act) {
#pragma unroll
                        for (int j = 0; j < 4; ++j) { v0[j] = gelu_tanh(v0[j]); v1[j] = gelu_tanh(v1[j]); }
                    }
                    if (st) {
#pragma unroll
                        for (int j = 0; j < 4; ++j) { s1 += v0[j] + v1[j]; s2 += v0[j] * v0[j] + v1[j] * v1[j]; }
                    }
                    u32x4 w; w.x = cvt_pk_bf16(v0[0], v0[1]); w.y = cvt_pk_bf16(v0[2], v0[3]); w.z = cvt_pk_bf16(v1[0], v1[1]); w.w = cvt_pk_bf16(v1[2], v1[3]);
                    __builtin_nontemporal_store(w, (u32x4*)(rowp + bj * HALF));
                }
                if (st && lnstat) {
                    s1 += __shfl_xor(s1, 16); s1 += __shfl_xor(s1, 32); s2 += __shfl_xor(s2, 16); s2 += __shfl_xor(s2, 32);
                    if (fq == 0) { unsafeAtomicAdd(lnstat + 2 * row, s1); unsafeAtomicAdd(lnstat + 2 * row + 1, s2); }
                }
            }
    }
};
struct EpiOut {
    static constexpr bool PERM = false, AFTER_DRAIN = false, MID = false, MIDLOOP = true;
    bf16_t* x1b; float* ss2; const PG8_LAS f32x2* sct;
    __device__ __forceinline__ void midloop(f32x4 (&acc)[2][2][4][2], const Unit& u, int wr, int fr) const {
        const PG8_LAS f32x2* p = sct + u.slot * 256 + wr * 64 + fr;
#pragma unroll
        for (int ai = 0; ai < 2; ++ai)
#pragma unroll
            for (int m = 0; m < 4; ++m) {
                const float ratio = p[ai * HALF + m * 16][0];
#pragma unroll
                for (int bj = 0; bj < 2; ++bj)
#pragma unroll
                    for (int n = 0; n < 2; ++n) acc[ai][bj][m][n] *= ratio;
            }
    }
    __device__ __forceinline__ void operator()(const f32x4 (&acc)[2][2][4][2], const Unit& u, int wr, int wc, int fr, int fq) const {
        const int row0 = u.pm * BM + wr * 64 + fr, col0 = u.pn * BM + wc * 32 + 4 * fq;
        const PG8_LAS f32x2* p = sct + u.slot * 256 + wr * 64 + fr;
#pragma unroll
        for (int ai = 0; ai < 2; ++ai)
#pragma unroll
            for (int m = 0; m < 4; ++m) {
                const int row = row0 + ai * HALF + m * 16; const float rg = p[ai * HALF + m * 16][1];
                bf16_t* brow = x1b + (size_t)row * DM + col0; float sq = 0.f;
#pragma unroll
                for (int bj = 0; bj < 2; ++bj)
#pragma unroll
                    for (int n = 0; n < 2; ++n) {
                        const u32x2 xw = *(const u32x2*)(brow + bj * HALF + n * 16);
                        f32x4 v = acc[ai][bj][m][n] * rg;
                        v[0] += __builtin_bit_cast(float, xw.x << 16); v[1] += __builtin_bit_cast(float, xw.x & 0xffff0000u); v[2] += __builtin_bit_cast(float, xw.y << 16); v[3] += __builtin_bit_cast(float, xw.y & 0xffff0000u);
                        u32x2 w; w.x = cvt_pk_bf16(v[0], v[1]); w.y = cvt_pk_bf16(v[2], v[3]); *(u32x2*)(brow + bj * HALF + n * 16) = w;
                        sq += (v[0] * v[0] + v[1] * v[1]) + (v[2] * v[2] + v[3] * v[3]);
                    }
                sq += __shfl_xor(sq, 16); sq += __shfl_xor(sq, 32);
                if (fq == 0) unsafeAtomicAdd(ss2 + row, sq);
            }
    }
};
struct EpiUp {
    static constexpr bool PERM = true, AFTER_DRAIN = false, MID = false, MIDLOOP = false;
    bf16_t* H; const float* ss2;
    __device__ __forceinline__ void operator()(const f32x4 (&acc)[2][2][4][2], const Unit& u, int wr, int wc, int fr, int fq) const {
        const int row0 = u.pm * BM + wr * 64 + fr, col0 = u.pn * BM + wc * 32 + 8 * fq;
#pragma unroll
        for (int ai = 0; ai < 2; ++ai)
#pragma unroll
            for (int m = 0; m < 4; ++m) {
                const int row = row0 + ai * HALF + m * 16; const float rs = 1.0f / sqrtf(ss2[row] * (1.0f / 2048.0f) + EPSN);
                bf16_t* rowp = H + (size_t)row * DFF + col0;
#pragma unroll
                for (int bj = 0; bj < 2; ++bj) {
                    f32x4 v0 = acc[ai][bj][m][0] * rs, v1 = acc[ai][bj][m][1] * rs;
#pragma unroll
                    for (int j = 0; j < 4; ++j) { v0[j] = fmaxf(v0[j], 0.f); v0[j] *= v0[j]; v1[j] = fmaxf(v1[j], 0.f); v1[j] *= v1[j]; }
                    u32x4 w; w.x = cvt_pk_bf16(v0[0], v0[1]); w.y = cvt_pk_bf16(v0[2], v0[3]); w.z = cvt_pk_bf16(v1[0], v1[1]); w.w = cvt_pk_bf16(v1[2], v1[3]);
                    *(u32x4*)(rowp + bj * HALF) = w;
                }
            }
    }
};
struct EpiDown {
    static constexpr bool PERM = false, AFTER_DRAIN = false, MID = false, MIDLOOP = false;
    float* out; const bf16_t* x1b;
    __device__ __forceinline__ void operator()(const f32x4 (&acc)[2][2][4][2], const Unit& u, int wr, int wc, int fr, int fq) const {
        const int row0 = u.pm * BM + wr * 64 + fr, col0 = u.pn * BM + wc * 32 + 4 * fq;
#pragma unroll
        for (int ai = 0; ai < 2; ++ai)
#pragma unroll
            for (int m = 0; m < 4; ++m) {
                const size_t off = (size_t)(row0 + ai * HALF + m * 16) * DM + col0;
#pragma unroll
                for (int bj = 0; bj < 2; ++bj)
#pragma unroll
                    for (int n = 0; n < 2; ++n) { const u32x2 xw = *(const u32x2*)(x1b + off + bj * HALF + n * 16); f32x4 v = acc[ai][bj][m][n];
                        v[0] += __builtin_bit_cast(float, xw.x << 16); v[1] += __builtin_bit_cast(float, xw.x & 0xffff0000u); v[2] += __builtin_bit_cast(float, xw.y << 16); v[3] += __builtin_bit_cast(float, xw.y & 0xffff0000u);
                        __builtin_nontemporal_store(v, (f32x4*)(out + off + bj * HALF + n * 16)); }
            }
    }
};

template <class Epi, class Sched, bool ALIGN_EPI = false, bool SP2 = false>
__device__ __forceinline__ void gemm_phase(PG8_LAS unsigned char* lds, const Gemm g, const Sched& S, const Epi& E) {
    int tid_ = threadIdx.x; asm volatile("" : "+v"(tid_));
    const int tid = tid_, wid = __builtin_amdgcn_readfirstlane(tid >> 6), lane = tid & 63, wr = wid >> 2, wc = wid & 3, fr = lane & 15, fq = lane >> 4;
    const int K = g.K, nt = K / BK, LD = g.ld;
    unsigned voffA[2], voffB[2];
#pragma unroll
    for (int i = 0; i < 2; ++i) { int R, C; stage_rc(tid * 16 + i * 8192, R, C); const int Rb = Epi::PERM ? ((R & ~31) + perm32(R & 31)) : R;
        voffA[i] = (unsigned)(R * LD + C) * 2u; voffB[i] = (unsigned)(Rb * LD + C) * 2u; }
    const size_t kstep = (size_t)(BK * 2);
    const size_t hstep = (size_t)HALF * LD * 2;
    const size_t tstep = 2 * hstep;
    const unsigned ldsw = (unsigned)wid * 1024u;
    const int aoff = lds_byte(wr * 64 + fr, fq * 8), boff = lds_byte(wc * 32 + fr, fq * 8);
#define PG8_SA(b, h) (((b) * 2 + (h)) * HTB)
#define PG8_SB(b, h) ((4 + (b) * 2 + (h)) * HTB)
#define PG8_STAGE(bufoff, gbase, voff) do { _Pragma("unroll") for (int _i = 0; _i < 2; ++_i) \
        __builtin_amdgcn_global_load_lds((const unsigned*)((const char*)(gbase) + (voff)[_i]), (PG8_LAS unsigned*)(lds + (bufoff) + ldsw + _i * 8192), 16, 0, 0); } while (0)
#define PG8_LDA(dst, b, h) do { _Pragma("unroll") for (int m = 0; m < 4; ++m) _Pragma("unroll") for (int k = 0; k < 2; ++k) dst[m][k] = *(const PG8_LAS bf16x8*)(lds + PG8_SA(b, h) + aoff + m * 2048 + k * 1024); } while (0)
#define PG8_LDB(dst, b, h) do { _Pragma("unroll") for (int n = 0; n < 2; ++n) _Pragma("unroll") for (int k = 0; k < 2; ++k) dst[n][k] = *(const PG8_LAS bf16x8*)(lds + PG8_SB(b, h) + boff + n * 2048 + k * 1024); } while (0)
#define PG8_MMA(ai, bj, At, Bt) do { __builtin_amdgcn_s_setprio(1); _Pragma("unroll") for (int m = 0; m < 4; ++m) _Pragma("unroll") for (int n = 0; n < 2; ++n) _Pragma("unroll") for (int k = 0; k < 2; ++k) \
        acc[ai][bj][m][n] = __builtin_amdgcn_mfma_f32_16x16x32_bf16(Bt[n][k], At[m][k], acc[ai][bj][m][n], 0, 0, 0); __builtin_amdgcn_s_setprio(0); } while (0)
#define PG8_WAIT_V(n) asm volatile("s_waitcnt vmcnt(" #n ")" ::: "memory")
#define PG8_WAIT_L(n) asm volatile("s_waitcnt lgkmcnt(" #n ")" ::: "memory")
#define PG8_BAR __builtin_amdgcn_s_barrier()
#define PG8_SCHED __builtin_amdgcn_sched_barrier(0)
    Unit cur, nxt; int ui = 0;
    if (!S.next(0, cur)) return;
    f32x4 acc[2][2][4][2];
#pragma unroll
    for (int a = 0; a < 2; ++a)
#pragma unroll
        for (int b = 0; b < 2; ++b)
#pragma unroll
            for (int m = 0; m < 4; ++m)
#pragma unroll
                for (int n = 0; n < 2; ++n) acc[a][b][m][n] = (f32x4){0.f, 0.f, 0.f, 0.f};
    bf16x8 At[4][2], B0[2][2], B1[2][2];
    const size_t khstep = (size_t)K * 2;
    const char* cA = (const char*)g.A + (size_t)cur.pm * tstep + cur.kh * khstep; const char* cB = (const char*)g.Bt + (size_t)cur.pn * tstep + cur.kh * khstep;
    S.a_ready(cur);
    if constexpr (SP2) {
        PG8_STAGE(PG8_SB(0, 0), cB, voffB); PG8_STAGE(PG8_SB(0, 1), cB + hstep, voffB); PG8_STAGE(PG8_SA(0, 0), cA, voffA); PG8_STAGE(PG8_SA(0, 1), cA + hstep, voffA);
        if (wr == 1) PG8_BAR;
        PG8_WAIT_V(2); PG8_BAR;
        PG8_STAGE(PG8_SB(1, 0), cB + kstep, voffB); PG8_STAGE(PG8_SA(1, 0), cA + kstep, voffA); PG8_STAGE(PG8_SB(1, 1), cB + hstep + kstep, voffB);
        PG8_WAIT_V(6); PG8_BAR;
    } else {
        PG8_STAGE(PG8_SB(0, 0), cB, voffB); PG8_STAGE(PG8_SA(0, 0), cA, voffA); PG8_STAGE(PG8_SB(0, 1), cB + hstep, voffB); PG8_STAGE(PG8_SA(0, 1), cA + hstep, voffA);
        if (wr == 1) PG8_BAR;
        PG8_WAIT_V(4); PG8_BAR;
        PG8_STAGE(PG8_SB(1, 0), cB + kstep, voffB); PG8_STAGE(PG8_SA(1, 0), cA + kstep, voffA); PG8_STAGE(PG8_SB(1, 1), cB + hstep + kstep, voffB);
        PG8_WAIT_V(6); PG8_BAR;
    }
    for (;;) {
        const bool has_next = S.next(ui + 1, nxt);
        const char* nA = has_next ? (const char*)g.A + (size_t)nxt.pm * tstep + nxt.kh * khstep : cA; const char* nB = has_next ? (const char*)g.Bt + (size_t)nxt.pn * tstep + nxt.kh * khstep : cB;
        for (int t = 0; t < nt; t += 2) {
            const bool last = (t == nt - 2);
            const char* a1 = cA + (size_t)(t + 1) * kstep;
            const char* a2 = last ? nA : cA + (size_t)(t + 2) * kstep; const char* b2 = last ? nB : cB + (size_t)(t + 2) * kstep;
            const char* a3 = a2 + kstep; const char* b3 = b2 + kstep;
            if (last && has_next) S.a_ready(nxt);
            if constexpr (Epi::MIDLOOP) { if (t == (nt >> 1)) E.midloop(acc, cur, wr, fr); }
            if constexpr (SP2) {
            PG8_LDB(B0, 0, 0); PG8_LDB(B1, 0, 1); PG8_SCHED; PG8_LDA(At, 0, 0); PG8_STAGE(PG8_SA(1, 1), a1 + hstep, voffA);
            PG8_WAIT_V(8); PG8_WAIT_L(0); PG8_BAR; PG8_MMA(0, 0, At, B0); PG8_MMA(0, 1, At, B1); PG8_BAR; PG8_SCHED;
            PG8_LDA(At, 0, 1); PG8_STAGE(PG8_SB(0, 0), b2, voffB); PG8_STAGE(PG8_SB(0, 1), b2 + hstep, voffB); PG8_STAGE(PG8_SA(0, 0), a2, voffA);
            PG8_WAIT_V(8); PG8_WAIT_L(0); PG8_BAR; PG8_MMA(1, 0, At, B0); PG8_MMA(1, 1, At, B1); PG8_BAR; PG8_SCHED;
            PG8_LDB(B0, 1, 0); PG8_LDB(B1, 1, 1); PG8_SCHED; PG8_LDA(At, 1, 0); PG8_STAGE(PG8_SA(0, 1), a2 + hstep, voffA);
            PG8_WAIT_V(8); PG8_WAIT_L(0); PG8_BAR; PG8_MMA(0, 0, At, B0); PG8_MMA(0, 1, At, B1); PG8_BAR; PG8_SCHED;
            PG8_LDA(At, 1, 1); PG8_STAGE(PG8_SB(1, 0), b3, voffB); PG8_STAGE(PG8_SB(1, 1), b3 + hstep, voffB); PG8_STAGE(PG8_SA(1, 0), a3, voffA);
            PG8_WAIT_V(8); PG8_WAIT_L(0); PG8_BAR; PG8_MMA(1, 0, At, B0); PG8_MMA(1, 1, At, B1); PG8_BAR; PG8_SCHED;
            } else {
            PG8_LDB(B0, 0, 0); PG8_SCHED; PG8_LDA(At, 0, 0); PG8_STAGE(PG8_SA(1, 1), a1 + hstep, voffA);
            PG8_WAIT_L(8); PG8_BAR; PG8_WAIT_L(0); PG8_MMA(0, 0, At, B0); PG8_BAR; PG8_SCHED;
            PG8_LDB(B1, 0, 1); PG8_STAGE(PG8_SB(0, 0), b2, voffB);
            PG8_BAR; PG8_WAIT_L(0); PG8_MMA(0, 1, At, B1); PG8_BAR;
            PG8_LDA(At, 0, 1); PG8_STAGE(PG8_SA(0, 0), a2, voffA);
            PG8_BAR; PG8_WAIT_L(0); PG8_MMA(1, 0, At, B0); PG8_BAR; PG8_SCHED;
            PG8_STAGE(PG8_SB(0, 1), b2 + hstep, voffB);
            PG8_WAIT_V(6); PG8_BAR; PG8_MMA(1, 1, At, B1); PG8_BAR;
            PG8_LDB(B0, 1, 0); PG8_SCHED; PG8_LDA(At, 1, 0); PG8_STAGE(PG8_SA(0, 1), a2 + hstep, voffA);
            PG8_WAIT_L(8); PG8_BAR; PG8_WAIT_L(0); PG8_MMA(0, 0, At, B0); PG8_BAR; PG8_SCHED;
            PG8_LDB(B1, 1, 1); PG8_STAGE(PG8_SB(1, 0), b3, voffB);
            PG8_BAR; PG8_WAIT_L(0); PG8_MMA(0, 1, At, B1); PG8_BAR;
            PG8_LDA(At, 1, 1); PG8_STAGE(PG8_SA(1, 0), a3, voffA);
            PG8_BAR; PG8_WAIT_L(0); PG8_MMA(1, 0, At, B0); PG8_BAR; PG8_SCHED;
            PG8_STAGE(PG8_SB(1, 1), b3 + hstep, voffB);
            PG8_WAIT_V(6); PG8_BAR; PG8_MMA(1, 1, At, B1); PG8_BAR;
            }
        }
        if constexpr (ALIGN_EPI) { if (wr == 0) PG8_BAR; }
        bool keep = false;
        if constexpr (Epi::MID) { if (cur.kh == 0) { E.mid(acc, cur, wr, wc, fr, fq); keep = true; } else E(acc, cur, wr, wc, fr, fq); }
        else if constexpr (!Epi::AFTER_DRAIN) { E(acc, cur, wr, wc, fr, fq); S.done(cur); }
        if (!has_next) break;
        if (!keep) {
#pragma unroll
        for (int a = 0; a < 2; ++a)
#pragma unroll
            for (int b = 0; b < 2; ++b)
#pragma unroll
                for (int m = 0; m < 4; ++m)
#pragma unroll
                    for (int n = 0; n < 2; ++n) acc[a][b][m][n] = (f32x4){0.f, 0.f, 0.f, 0.f};
        }
        cur = nxt; cA = nA; cB = nB; ++ui;
        if constexpr (ALIGN_EPI) { if (wr == 1) PG8_BAR; }
    }
    PG8_WAIT_V(0);
    if constexpr (!ALIGN_EPI) { if (wr == 0) PG8_BAR; }
    PG8_BAR;
    if constexpr (Epi::AFTER_DRAIN) { E.fused(acc, cur, wr, wc, fr, fq, lds, wid, lane); S.done(cur); }
#undef PG8_SA
#undef PG8_SB
#undef PG8_STAGE
#undef PG8_LDA
#undef PG8_LDB
#undef PG8_MMA
#undef PG8_WAIT_V
#undef PG8_WAIT_L
#undef PG8_BAR
#undef PG8_SCHED
}
}

#define LAS __attribute__((address_space(3)))
typedef unsigned short bf16;
typedef float f32x4 __attribute__((ext_vector_type(4)));
typedef short bf16x8 __attribute__((ext_vector_type(8)));
typedef short s16x4 __attribute__((ext_vector_type(4)));
typedef unsigned v4u __attribute__((ext_vector_type(4)));
typedef unsigned v2u __attribute__((ext_vector_type(2)));
typedef float f32x2 __attribute__((ext_vector_type(2)));
constexpr int NW = 8, NT = 512;
constexpr int T = 16384, D = 2048, INW = 3584, FF = 8192, TH = 8192;
constexpr int LDS_BYTES = 147456, LDS_BARST = LDS_BYTES - 64;
constexpr size_t MiB = 1u << 20;
constexpr size_t WS_BAR = 2 * MiB + 65536  , WS_PAR = 2 * MiB, WS_LNSTAT = 0, WS_SS2 = 131072, WS_R1 = 196608, WS_SSMIX = 262144, WS_TAB = 1310720, WS_WSP = 1835008;
constexpr size_t WS_WIN = 3 * MiB, WS_WOUT = 17 * MiB, WS_WUP = 25 * MiB, WS_WDOWN = 57 * MiB, WS_XB = 89 * MiB, WS_HID = 153 * MiB, WS_MIX = 153 * MiB, WS_END = 281 * MiB;
constexpr int PAR_GQ = 0, PAR_GK = 128, PAR_SINK = 256, PAR_GV = 512, PAR_BV = 1536, PAR_BSP = 2560, PAR_N = 3584;
constexpr int C_Q = 0, C_K = 1024, C_V = 1280, C_U = 1536, C_VG = 2560;
constexpr int QK_STRIDE = 272, V_STRIDE = 288;
constexpr int LQ = 0, LK = 2 * 128 * QK_STRIDE, LV = LK + 128 * QK_STRIDE;
static_assert(LV + 128 * V_STRIDE <= LDS_BYTES, "attention LDS");
constexpr float LOG2E = 1.4426950408889634f;

__device__ __forceinline__ unsigned f2bf(float f) { unsigned u = __builtin_bit_cast(unsigned, f); return (u + 0x7fffu + ((u >> 16) & 1u)) >> 16; }
__device__ __forceinline__ unsigned pk2(float lo, float hi) { return pg8::cvt_pk_bf16(lo, hi); }
__device__ __forceinline__ float bflo(unsigned w) { return __builtin_bit_cast(float, w << 16); }
__device__ __forceinline__ float bfhi(unsigned w) { return __builtin_bit_cast(float, w & 0xffff0000u); }
__device__ __forceinline__ float wave_sum(float v) {
#pragma unroll
    for (int o = 1; o < 64; o <<= 1) v += __shfl_xor(v, o);
    return v;
}
#define LDS_WAIT() asm volatile("s_waitcnt lgkmcnt(0)" ::: "memory")

#define RLX_AGENT __ATOMIC_RELAXED, __HIP_MEMORY_SCOPE_AGENT
#define XB_TMO      128
#define XB_XCNT(j)  (256  + 64 * (j))
#define XB_XSUB(j)  (1280 + 64 * (j))
#define XB_XGEN(j)  (2304 + 64 * (j))
#define XB_TOP      3328
#define XB_TOPGEN   3392
#define XCD_BAR_WORDS 3456
#define XB_SPIN_CAP (1u << 18)

__device__ __forceinline__ unsigned xb_ld(unsigned* p)              { return __hip_atomic_load(p, __ATOMIC_RELAXED, __HIP_MEMORY_SCOPE_AGENT); }
__device__ __forceinline__ unsigned xb_add(unsigned* p, unsigned v) { return __hip_atomic_fetch_add(p, v, __ATOMIC_RELAXED, __HIP_MEMORY_SCOPE_AGENT); }
__device__ __forceinline__ unsigned xb_xcc_id() { return (unsigned)__builtin_amdgcn_s_getreg((3 << 11) | 20) & 0xFu; }
#define XB_SPIN(cond, bar) do { unsigned _sp = 0; while (cond) { __builtin_amdgcn_s_sleep(1); \
    if ((++_sp & 255u) == 0u) { if (xb_ld(&(bar)[XB_TMO])) break; if (_sp > XB_SPIN_CAP) { atomicAdd(&(bar)[XB_TMO], 1u); break; } } } } while (0)

struct XcdBarrier {
    unsigned* bar; unsigned x;
    volatile LAS unsigned* st;
};

__device__ __forceinline__ XcdBarrier xcd_barrier_post(unsigned* bar, volatile LAS unsigned* st) {
    XcdBarrier b; b.bar = bar; b.x = xb_xcc_id(); b.st = st;
    if (threadIdx.x == 0) (void)xb_add(&bar[XB_XCNT(b.x)], 1u);
    return b;
}
__device__ __forceinline__ void xcd_barrier_complete(unsigned* bar, unsigned x, unsigned& nloc, unsigned& nx) {
    const unsigned G = gridDim.x * gridDim.y * gridDim.z;
    unsigned sum, cnt, mine, sp = 0u;
    for (;;) {
        sum = 0u; cnt = 0u; mine = 0u;
#pragma unroll
        for (unsigned j = 0; j < 16; ++j) { const unsigned c = xb_ld(&bar[XB_XCNT(j)]); sum += c; cnt += (c > 0u) ? 1u : 0u; mine = (j == x) ? c : mine; }
        if (sum == G) break;
        __builtin_amdgcn_s_sleep(1);
        if ((++sp & 255u) == 0u) { if (xb_ld(&bar[XB_TMO])) break; if (sp > XB_SPIN_CAP) { atomicAdd(&bar[XB_TMO], 1u); break; } }
    }
    nloc = mine > 0u ? mine : 1u; nx = cnt > 0u ? cnt : 1u;
}

__device__ __forceinline__ void xcd_barrier(const XcdBarrier& b) {
    asm volatile("s_waitcnt vmcnt(0)" ::: "memory");
    __syncthreads();
    if (threadIdx.x == 0) {
        unsigned* bar = b.bar;
        __builtin_amdgcn_s_waitcnt(0);
        unsigned nloc = b.st[0], nx = b.st[1];
        if (nloc == 0u) { xcd_barrier_complete(bar, b.x, nloc, nx); b.st[0] = nloc; b.st[1] = nx; }
        const unsigned old = xb_add(&bar[XB_XSUB(b.x)], 1u);
        const unsigned gen = old / nloc;
        if (old + 1u == (gen + 1u) * nloc) {
            __builtin_amdgcn_fence(__ATOMIC_RELEASE, "agent");
            asm volatile("s_waitcnt vmcnt(0)" ::: "memory");
            const unsigned og = xb_add(&bar[XB_TOP], 1u);
            const unsigned tg = og / nx;
            if (og + 1u == (tg + 1u) * nx) xb_add(&bar[XB_TOPGEN], 1u);
            else XB_SPIN(xb_ld(&bar[XB_TOPGEN]) == tg, bar);
            __builtin_amdgcn_fence(__ATOMIC_ACQUIRE, "agent");
            xb_add(&bar[XB_XGEN(b.x)], 1u);
            asm volatile("s_waitcnt vmcnt(0)" ::: "memory");
        } else {
            XB_SPIN(xb_ld(&bar[XB_XGEN(b.x)]) == gen, bar);
            __builtin_amdgcn_fence(__ATOMIC_ACQUIRE, "agent");
            asm volatile("s_waitcnt vmcnt(0)" ::: "memory");
        }
    }
    __syncthreads();
}


struct Args {
    const float *xp, *xs, *g_mix, *w_in, *g_q, *g_k, *sink, *g_v_ln, *b_v_ln, *w_sp, *b_sp, *g_ao, *g_go, *w_out, *g_ffn, *w_up, *w_down;
    float* out; unsigned char* ws;
};

__device__ __forceinline__ void transpose_tile(const float* __restrict__ W, int K, int N, bf16* __restrict__ WT, const float* __restrict__ ga, const float* __restrict__ gb, int gsplit, LAS float* scr, int item, int lane) {
    const int nkb = K / 64, nb = item / nkb, kb = item % nkb, k0 = 64 * kb, n0 = 64 * nb;
    const int c = lane & 15, kq = lane >> 4;
    f32x4 v[16];
#pragma unroll
    for (int i = 0; i < 16; ++i) v[i] = __builtin_nontemporal_load((const f32x4*)(W + (size_t)(k0 + 4 * i + kq) * N + n0 + 4 * c));
#pragma unroll
    for (int i = 0; i < 16; ++i) {
        const int k = k0 + 4 * i + kq; float g = 1.0f; if (ga) g = (k < gsplit) ? ga[k] : gb[k - gsplit];
        LAS float* p = scr + (4 * i + kq) * 65 + 4 * c; p[0] = v[i][0] * g; p[1] = v[i][1] * g; p[2] = v[i][2] * g; p[3] = v[i][3] * g;
    }
    LDS_WAIT(); asm volatile("" ::: "memory");
    const int kc = lane & 7;
#pragma unroll
    for (int j = 0; j < 8; ++j) { const int n = (lane >> 3) + 8 * j; const LAS float* sp = scr + (8 * kc) * 65 + n;
        v4u o; o.x = pk2(sp[0 * 65], sp[1 * 65]); o.y = pk2(sp[2 * 65], sp[3 * 65]); o.z = pk2(sp[4 * 65], sp[5 * 65]); o.w = pk2(sp[6 * 65], sp[7 * 65]);
        *(v4u*)(WT + (size_t)(n0 + n) * K + k0 + 8 * kc) = o; }
    LDS_WAIT(); asm volatile("" ::: "memory");
}

__device__ __forceinline__ bf16x8 tr_frag(const LAS unsigned char* p0, const LAS unsigned char* p1) {
    const s16x4 a = __builtin_amdgcn_ds_read_tr16_b64_v4i16((LAS s16x4*)p0);
    const s16x4 b = __builtin_amdgcn_ds_read_tr16_b64_v4i16((LAS s16x4*)p1);
    return __builtin_shufflevector(a, b, 0, 1, 2, 3, 4, 5, 6, 7);
}
__device__ __forceinline__ void tile_ld(v4u (&raw)[4], const bf16* proj, int tok0, int colbase, int tid) {
    const int c = tid & 15, r0 = tid >> 4;
#pragma unroll
    for (int p = 0; p < 4; ++p) raw[p] = *(const v4u*)(proj + (size_t)(tok0 + r0 + 32 * p) * INW + colbase + 8 * c);
}
template <int STRIDE> __device__ __forceinline__ void tile_st(const v4u (&raw)[4], LAS unsigned char* dst, int tid) {
    const int c = tid & 15, r0 = tid >> 4;
#pragma unroll
    for (int p = 0; p < 4; ++p) *(LAS v4u*)(dst + (r0 + 32 * p) * STRIDE + c * 16) = raw[p];
}

__device__ __forceinline__ void attn_unit(const bf16* proj, unsigned char* ws, LAS unsigned char* lds, int a) {
    int tid = threadIdx.x; asm volatile("" : "+v"(tid)); const int lane = tid & 63, wave = __builtin_amdgcn_readfirstlane(tid >> 6);
    const float* par = (const float*)(ws + WS_PAR);
    bf16* mix = (bf16*)(ws + WS_MIX); float* ssmix = (float*)(ws + WS_SSMIX);
    const int gb = a >> 2, kvh = (a >> 1) & 1, hp = a & 1;
    int n, nb; if (gb < 64) { nb = 32; n = gb & 31; } else { nb = 16; n = (gb - 64) & 15; }
    const int tok0 = gb * 128, hw = wave >> 2, rq = wave & 3, fr = lane & 15, fq = lane >> 4;
    const int h0 = kvh * 4 + hp * 2, h = h0 + hw;
    LAS unsigned char* QS = lds + LQ; LAS unsigned char* KS = lds + LK; LAS unsigned char* VS = lds + LV;
    const int kb0 = (n > 0) ? n - 1 : 0, kb1 = (n + 1 < nb) ? n + 1 : nb - 1;
    v4u kr[4], vr[4];
    {
        v4u q0[4], q1[4];
        tile_ld(q0, proj, tok0, C_Q + h0 * 128, tid); tile_ld(q1, proj, tok0, C_Q + (h0 + 1) * 128, tid);
        tile_ld(kr, proj, tok0 + (kb0 - n) * 128, C_K + kvh * 128, tid); tile_ld(vr, proj, tok0 + (kb0 - n) * 128, C_V + kvh * 128, tid);
        __syncthreads();
        tile_st<QK_STRIDE>(q0, QS, tid); tile_st<QK_STRIDE>(q1, QS + 128 * QK_STRIDE, tid);
    }
    const LAS unsigned char* qbase = QS + hw * (128 * QK_STRIDE) + (rq * 32 + fr) * QK_STRIDE + (8 * fq) * 2;
    const float sk2 = par[PAR_SINK + h] * LOG2E;
    float mrow[2], lrow[2]; mrow[0] = mrow[1] = sk2; lrow[0] = lrow[1] = (fq == 0) ? 1.0f : 0.0f;
    f32x4 O[2][8];
#pragma unroll
    for (int rt = 0; rt < 2; ++rt)
#pragma unroll
        for (int dt = 0; dt < 8; ++dt) O[rt][dt] = (f32x4){0.f, 0.f, 0.f, 0.f};
#pragma unroll 1
    for (int kb = kb0; kb <= kb1; ++kb) {
        if (kb != kb0) __syncthreads();
        tile_st<QK_STRIDE>(kr, KS, tid); tile_st<V_STRIDE>(vr, VS, tid);
        __syncthreads();
        if (kb < kb1) { tile_ld(kr, proj, tok0 + (kb + 1 - n) * 128, C_K + kvh * 128, tid); tile_ld(vr, proj, tok0 + (kb + 1 - n) * 128, C_V + kvh * 128, tid); }
        f32x4 st[2][8];
#pragma unroll
        for (int kt = 0; kt < 8; ++kt) { st[0][kt] = (f32x4){0.f, 0.f, 0.f, 0.f}; st[1][kt] = (f32x4){0.f, 0.f, 0.f, 0.f}; }
#pragma unroll
        for (int s = 0; s < 4; ++s) {
            const bf16x8 qa = *(const LAS bf16x8*)(qbase + 64 * s), qb = *(const LAS bf16x8*)(qbase + 16 * QK_STRIDE + 64 * s);
#pragma unroll
            for (int kt = 0; kt < 8; ++kt) {
                const bf16x8 kf = *(const LAS bf16x8*)(KS + (16 * kt + fr) * QK_STRIDE + (32 * s + 8 * fq) * 2);
                st[0][kt] = __builtin_amdgcn_mfma_f32_16x16x32_bf16(kf, qa, st[0][kt], 0, 0, 0);
                st[1][kt] = __builtin_amdgcn_mfma_f32_16x16x32_bf16(kf, qb, st[1][kt], 0, 0, 0);
            }
        }
        bf16x8 pb[2][4];
#pragma unroll
        for (int rt = 0; rt < 2; ++rt) {
            const int qi = rq * 32 + rt * 16 + fr;
            if (kb != n) {
                const int sgn = (kb < n) ? 1 : -1, dbase = sgn * (4 * fq - qi);
#pragma unroll
                for (int kt = 0; kt < 8; ++kt)
#pragma unroll
                    for (int r = 0; r < 4; ++r) { const int dd = dbase + sgn * (16 * kt + r); st[rt][kt][r] += __builtin_bit_cast(float, (unsigned)(dd >> 31) & 0xF149F2CAu); }
            }
            float mx = -1e30f;
#pragma unroll
            for (int kt = 0; kt < 8; ++kt)
#pragma unroll
                for (int r = 0; r < 4; ++r) mx = fmaxf(mx, st[rt][kt][r]);
            mx = fmaxf(mx, __shfl_xor(mx, 16)); mx = fmaxf(mx, __shfl_xor(mx, 32));
            const float mnew = fmaxf(mrow[rt], mx), alpha = __builtin_amdgcn_exp2f(mrow[rt] - mnew);
            mrow[rt] = mnew; float ls = lrow[rt] * alpha;
#pragma unroll
            for (int dt = 0; dt < 8; ++dt) O[rt][dt] *= alpha;
#pragma unroll
            for (int kt = 0; kt < 8; ++kt)
#pragma unroll
                for (int r = 0; r < 4; ++r) { const float p = __builtin_amdgcn_exp2f(st[rt][kt][r] - mnew); st[rt][kt][r] = p; ls += p; }
            lrow[rt] = ls;
#pragma unroll
            for (int tp = 0; tp < 4; ++tp) {
                v4u w; w.x = pk2(st[rt][2 * tp][0], st[rt][2 * tp][1]); w.y = pk2(st[rt][2 * tp][2], st[rt][2 * tp][3]);
                w.z = pk2(st[rt][2 * tp + 1][0], st[rt][2 * tp + 1][1]); w.w = pk2(st[rt][2 * tp + 1][2], st[rt][2 * tp + 1][3]);
                pb[rt][tp] = __builtin_bit_cast(bf16x8, w);
            }
        }
#pragma unroll
        for (int dt = 0; dt < 8; ++dt)
#pragma unroll
            for (int tp = 0; tp < 4; ++tp) {
                const LAS unsigned char* p0 = VS + (32 * tp + 4 * fq + (fr >> 2)) * V_STRIDE + (16 * dt + 4 * (fr & 3)) * 2;
                const bf16x8 vf = tr_frag(p0, p0 + 16 * V_STRIDE);
                O[0][dt] = __builtin_amdgcn_mfma_f32_16x16x32_bf16(vf, pb[0][tp], O[0][dt], 0, 0, 0);
                O[1][dt] = __builtin_amdgcn_mfma_f32_16x16x32_bf16(vf, pb[1][tp], O[1][dt], 0, 0, 0);
            }
    }
#pragma unroll
    for (int rt = 0; rt < 2; ++rt) {
        float lt = lrow[rt]; lt += __shfl_xor(lt, 16); lt += __shfl_xor(lt, 32);
        const float inv = 1.0f / lt; const int tok = tok0 + rq * 32 + rt * 16 + fr; float ss = 0.f;
        bf16* orow = mix + (size_t)tok * D + h * 128 + 4 * fq;
#pragma unroll
        for (int dt = 0; dt < 8; ++dt) { const f32x4 o = O[rt][dt] * inv; ss += (o[0] * o[0] + o[1] * o[1]) + (o[2] * o[2] + o[3] * o[3]);
            v2u w; w.x = pk2(o[0], o[1]); w.y = pk2(o[2], o[3]); *(v2u*)(orow + 16 * dt) = w; }
        ss += __shfl_xor(ss, 16); ss += __shfl_xor(ss, 32);
        if (fq == 0) unsafeAtomicAdd(ssmix + (size_t)tok * 2, ss);
    }
}

__device__ __forceinline__ void gmlp_unit(const bf16* proj, unsigned char* ws, LAS unsigned char* lds, int gu) {
    int tid = threadIdx.x; asm volatile("" : "+v"(tid)); const int lane = tid & 63, wave = __builtin_amdgcn_readfirstlane(tid >> 6);
    const float* par = (const float*)(ws + WS_PAR);
    const float* lnstat = (const float*)(ws + WS_LNSTAT); const bf16* wsp = (const bf16*)(ws + WS_WSP);
    bf16* mix = (bf16*)(ws + WS_MIX); float* ssmix = (float*)(ws + WS_SSMIX);
    const int gb = gu >> 3, h = gu & 7, tok0 = gb * 128, fr = lane & 15, fq = lane >> 4;
    LAS unsigned char* VN = lds;
    const int c = tid & 15, r0 = tid >> 4;
    v4u raw[4]; f32x2 stv[4];
    tile_ld(raw, proj, tok0, C_VG + h * 128, tid);
#pragma unroll
    for (int p = 0; p < 4; ++p) stv[p] = *(const f32x2*)(lnstat + 2 * (tok0 + r0 + 32 * p));
    const f32x4 g0 = *(const f32x4*)(par + PAR_GV + h * 128 + 8 * c), g1 = *(const f32x4*)(par + PAR_GV + h * 128 + 8 * c + 4);
    const f32x4 b0 = *(const f32x4*)(par + PAR_BV + h * 128 + 8 * c), b1 = *(const f32x4*)(par + PAR_BV + h * 128 + 8 * c + 4);
    bf16x8 wf[4];
#pragma unroll
    for (int s = 0; s < 4; ++s) wf[s] = *(const bf16x8*)(wsp + ((size_t)(h * 128 + 16 * wave + fr) * 128 + 32 * s + 8 * fq));
    const int tok = tok0 + 16 * wave + fr; const float bsp = par[PAR_BSP + h * 128 + 16 * wave + fr];
    const bf16* urow = proj + (size_t)tok * INW + C_U + h * 128 + 4 * fq; bf16* orow = mix + (size_t)tok * D + 1024 + h * 128 + 4 * fq;
    v2u uw[8];
#pragma unroll
    for (int ct = 0; ct < 8; ++ct) uw[ct] = *(const v2u*)(urow + 16 * ct);
    __syncthreads();
#pragma unroll
    for (int p = 0; p < 4; ++p) {
        const float mu = stv[p][0] * (1.0f / 1024.0f), var = fmaxf(stv[p][1] * (1.0f / 1024.0f) - mu * mu, 0.f), rstd = 1.0f / sqrtf(var + pg8::EPSN);
        float v[8];
        v[0] = bflo(raw[p].x); v[1] = bfhi(raw[p].x); v[2] = bflo(raw[p].y); v[3] = bfhi(raw[p].y); v[4] = bflo(raw[p].z); v[5] = bfhi(raw[p].z); v[6] = bflo(raw[p].w); v[7] = bfhi(raw[p].w);
#pragma unroll
        for (int e = 0; e < 4; ++e) { v[e] = (v[e] - mu) * rstd * g0[e] + b0[e]; v[4 + e] = (v[4 + e] - mu) * rstd * g1[e] + b1[e]; }
        v4u o; o.x = pk2(v[0], v[1]); o.y = pk2(v[2], v[3]); o.z = pk2(v[4], v[5]); o.w = pk2(v[6], v[7]);
        *(LAS v4u*)(VN + (r0 + 32 * p) * V_STRIDE + c * 16) = o;
    }
    __syncthreads();
    f32x4 acc[8];
#pragma unroll
    for (int ct = 0; ct < 8; ++ct) {
        acc[ct] = (f32x4){0.f, 0.f, 0.f, 0.f};
#pragma unroll
        for (int s = 0; s < 4; ++s) {
            const LAS unsigned char* p0 = VN + (32 * s + 8 * fq + (fr >> 2)) * V_STRIDE + (16 * ct + 4 * (fr & 3)) * 2;
            const bf16x8 vf = tr_frag(p0, p0 + 4 * V_STRIDE);
            acc[ct] = __builtin_amdgcn_mfma_f32_16x16x32_bf16(vf, wf[s], acc[ct], 0, 0, 0);
        }
    }
    float ss = 0.f;
#pragma unroll
    for (int ct = 0; ct < 8; ++ct) {
        const float o0 = bflo(uw[ct].x) * (acc[ct][0] + bsp), o1 = bfhi(uw[ct].x) * (acc[ct][1] + bsp), o2 = bflo(uw[ct].y) * (acc[ct][2] + bsp), o3 = bfhi(uw[ct].y) * (acc[ct][3] + bsp);
        ss += (o0 * o0 + o1 * o1) + (o2 * o2 + o3 * o3);
        v2u w; w.x = pk2(o0, o1); w.y = pk2(o2, o3); *(v2u*)(orow + 16 * ct) = w;
    }
    ss += __shfl_xor(ss, 16); ss += __shfl_xor(ss, 32);
    if (fq == 0) unsafeAtomicAdd(ssmix + (size_t)tok * 2 + 1, ss);
}

__device__ __forceinline__ void convert_out_down(const Args& A, LAS unsigned char* lds, int vcu, int G) {
    int tid = threadIdx.x; asm volatile("" : "+v"(tid)); const int lane = tid & 63, wave = __builtin_amdgcn_readfirstlane(tid >> 6);
    unsigned char* ws = A.ws;
    __syncthreads();
    LAS float* scr = (LAS float*)(lds + wave * 16640);
    constexpr int I_OUT0 = (D / 64) * (D / 64), I_DN0 = (FF / 64) * (D / 64);
    for (int it = vcu * NW + wave; it < I_OUT0 + I_DN0; it += G * NW) {
        if (it < I_OUT0) transpose_tile(A.w_out, D, D, (bf16*)(ws + WS_WOUT), A.g_ao, A.g_go, 1024, scr, it, lane);
        else transpose_tile(A.w_down, FF, D, (bf16*)(ws + WS_WDOWN), nullptr, nullptr, 0, scr, it - I_OUT0, lane);
    }
    __syncthreads();
}

template <int HF> __device__ __forceinline__ void ffn_half(const Args& A, LAS unsigned char* lds, int G, int bx, const XcdBarrier& xb) {
    unsigned char* ws = A.ws;
    bf16* HID = (bf16*)(ws + WS_HID);
    {
        pg8::Gemm g{(const bf16*)(ws + WS_XB) + (size_t)HF * TH * D, (const bf16*)(ws + WS_WUP), TH, FF, D, D}; pg8::StaticOrder S; S.init(TH, FF, G, bx, 4);
        pg8::EpiUp E{HID, (const float*)(ws + WS_SS2) + HF * TH};
        pg8::gemm_phase<pg8::EpiUp, pg8::StaticOrder, true, true>(lds, g, S, E);
    }
    xcd_barrier(xb);
    {
        pg8::Gemm g{HID, (const bf16*)(ws + WS_WDOWN), TH, D, FF, FF}; pg8::StaticOrder S; S.init(TH, D, G, bx, 4);
        pg8::EpiDown E{A.out + (size_t)HF * TH * D, (const bf16*)(ws + WS_XB) + (size_t)HF * TH * D};
        pg8::gemm_phase<pg8::EpiDown, pg8::StaticOrder, true, true>(lds, g, S, E);
    }
}

__global__ void __launch_bounds__(NT, 2) fwd_mega(Args A) {
    extern __shared__ __attribute__((aligned(16))) unsigned char lds_raw[];
    LAS unsigned char* lds = (LAS unsigned char*)lds_raw;
    cg::grid_group grid = cg::this_grid();
    const int tid = threadIdx.x, lane = tid & 63, wave = __builtin_amdgcn_readfirstlane(tid >> 6);
    const int G = gridDim.x, bx = blockIdx.x;
    const int vcu = (G % 8 == 0) ? (bx % 8) * (G / 8) + bx / 8 : bx;
    unsigned char* ws = A.ws;
    bf16* WinT = (bf16*)(ws + WS_WIN); bf16* WoutT = (bf16*)(ws + WS_WOUT); bf16* WupT = (bf16*)(ws + WS_WUP); bf16* WdownT = (bf16*)(ws + WS_WDOWN);
    bf16* XB = (bf16*)(ws + WS_XB); bf16* HID = (bf16*)(ws + WS_HID); bf16* MIX = (bf16*)(ws + WS_MIX);
    float* lnstat = (float*)(ws + WS_LNSTAT); float* ss2 = (float*)(ws + WS_SS2); float* r1 = (float*)(ws + WS_R1); float* ssmix = (float*)(ws + WS_SSMIX);
    bf16* PROJ = (bf16*)A.out;
    if (tid < 2) ((LAS unsigned*)(lds + LDS_BARST))[tid] = 0u;
    unsigned* barw = (unsigned*)(ws + WS_BAR);
    if (bx == 0) for (int i = tid; i < XCD_BAR_WORDS; i += NT) barw[i] = 0u;
    grid.sync();
    const XcdBarrier xbar = xcd_barrier_post(barw, (volatile LAS unsigned*)(lds + LDS_BARST));

    {
        const int gw = vcu * NW + wave, NGW = G * NW;
        LAS float* scr = (LAS float*)(lds + wave * 16640);
        constexpr int I_IN = (D / 64) * (INW / 64);
        for (int it = gw; it < I_IN; it += NGW) transpose_tile(A.w_in, D, INW, WinT, A.g_mix, A.g_mix, D, scr, it, lane);
        for (int m = gw; m < T; m += NGW) {
            const float* xrow = (m < 8192) ? A.xp + (size_t)m * D : A.xs + (size_t)(m - 8192) * D;
            const f32x4* xr = (const f32x4*)xrow + lane; f32x4 v[8]; float s = 0.f;
#pragma unroll
            for (int j = 0; j < 8; ++j) { v[j] = __builtin_nontemporal_load(xr + 64 * j); s += (v[j][0] * v[j][0] + v[j][1] * v[j][1]) + (v[j][2] * v[j][2] + v[j][3] * v[j][3]); }
            s = wave_sum(s);
            if (lane == 0) r1[m] = 1.0f / sqrtf(s * (1.0f / D) + pg8::EPSN);
            v2u* o8 = (v2u*)(XB + (size_t)m * D) + lane;
#pragma unroll
            for (int j = 0; j < 8; ++j) { v2u w; w.x = pk2(v[j][0], v[j][1]); w.y = pk2(v[j][2], v[j][3]); o8[64 * j] = w; }
        }
        const int gt = vcu * NT + tid, NGT = G * NT;
        for (int i = gt; i < 8 * 128 * 128; i += NGT) ((bf16*)(ws + WS_WSP))[i] = (bf16)f2bf(A.w_sp[i]);
        for (int i = gt; i < 4096 * 16; i += NGT) {
            const int pos = i >> 4, k = i & 15;
            const float inv_freq = __builtin_amdgcn_exp2f(-(float)k * (18.931568569324174f / 16.0f));
            const float ang = (float)pos * inv_freq, rev = ang * 0.15915494309189535f, fr = rev - floorf(rev);
            float* tp = (float*)(ws + WS_TAB) + 2 * (size_t)i; tp[0] = __builtin_amdgcn_cosf(fr); tp[1] = __builtin_amdgcn_sinf(fr);
        }
        for (int i = gt; i < PAR_N; i += NGT) {
            float v = 0.f;
            if (i < PAR_GK) v = A.g_q[i]; else if (i < PAR_SINK) v = A.g_k[i - PAR_GK]; else if (i < PAR_SINK + 8) v = A.sink[i - PAR_SINK];
            else if (i < PAR_GV) v = 0.f; else if (i < PAR_BV) v = A.g_v_ln[i - PAR_GV]; else if (i < PAR_BSP) v = A.b_v_ln[i - PAR_BV]; else v = A.b_sp[i - PAR_BSP];
            ((float*)(ws + WS_PAR))[i] = v;
        }
        for (int i = gt; i < 2 * T; i += NGT) { lnstat[i] = 0.f; ssmix[i] = 0.f; }
        for (int i = gt; i < T; i += NGT) ss2[i] = 0.f;
    }
    xcd_barrier(xbar);
    {
        pg8::Gemm g{XB, WinT, T, INW, D, D}; pg8::StaticOrder S; S.init(T, INW, G, bx, 4);
        pg8::EpiProj E{PROJ, r1, lnstat, (const float*)(ws + WS_PAR) + PAR_GQ, (const float*)(ws + WS_PAR) + PAR_GK, (const float*)(ws + WS_TAB), (LAS float*)(lds + 131072)};
        pg8::gemm_phase<pg8::EpiProj, pg8::StaticOrder, true, true>(lds, g, S, E);
        constexpr int NU = (T / 256) * (INW / 256);
        const int rem = NU % G, NH = (rem == 0) ? G : G - rem, hi = (rem == 0) ? bx : bx - rem;
        if (hi >= 0) {
            constexpr int I_UP = (D / 64) * (FF / 64);
            LAS float* scr = (LAS float*)(lds + wave * 16640);
            for (int it = hi * NW + wave; it < I_UP; it += NH * NW) transpose_tile(A.w_up, D, FF, WupT, A.g_ffn, A.g_ffn, D, scr, it, lane);
        }
    }
    xcd_barrier(xbar);
    if (!(vcu & 1)) convert_out_down(A, lds, vcu, G);
#pragma unroll 1
    for (int u = vcu; u < 1536; u += G) {
        if (u < 512) attn_unit(PROJ, ws, lds, u);
        else gmlp_unit(PROJ, ws, lds, u - 512);
    }
    if (vcu & 1) convert_out_down(A, lds, vcu, G);
    xcd_barrier(xbar);
    {
        pg8::Gemm g{MIX, WoutT, T, D, D, D}; pg8::StaticOrder S; S.init(T, D, G, bx, 4);
        LAS pg8::f32x2* sct = (LAS pg8::f32x2*)(lds + 131072);
        for (int e = tid; e < 7 * 256; e += NT) {
            pg8::Unit u; if (!S.next(e >> 8, u)) break;
            const pg8::f32x2 p = *(const pg8::f32x2*)(ssmix + (size_t)(u.pm * 256 + (e & 255)) * 2);
            const float va = p[0] * (1.0f / 1024.0f) + pg8::EPSN, vg = p[1] * (1.0f / 1024.0f) + pg8::EPSN;
            pg8::f32x2 o; o[1] = __builtin_amdgcn_rsqf(vg); o[0] = __builtin_amdgcn_rsqf(va) * __builtin_amdgcn_sqrtf(vg); sct[e] = o;
        }
        __syncthreads();
        pg8::EpiOut E{XB, ss2, sct};
        pg8::gemm_phase<pg8::EpiOut, pg8::StaticOrder, true, true>(lds, g, S, E);
    }
    xcd_barrier(xbar);
    ffn_half<0>(A, lds, G, bx, xbar);
    xcd_barrier(xbar);
    ffn_half<1>(A, lds, G, bx, xbar);
}

extern "C" void kernel_launch(void* const* d_in, const int* in_sizes, int n_in, void* d_out, int out_size, void* d_ws, size_t ws_size, hipStream_t stream) {
    static int grid = 0;
    if (grid == 0) {
        if (n_in != 17 || out_size != T * D || ws_size < WS_END) { fprintf(stderr, "kernel_launch: unexpected sizes n_in %d out %d ws %zu (need %zu)\n", n_in, out_size, ws_size, (size_t)WS_END); }
        int dev = 0, cus = 0, per_cu = 0;
        (void)hipGetDevice(&dev); (void)hipDeviceGetAttribute(&cus, hipDeviceAttributeMultiprocessorCount, dev);
        if (hipFuncSetAttribute((const void*)fwd_mega, hipFuncAttributeMaxDynamicSharedMemorySize, LDS_BYTES) != hipSuccess) fprintf(stderr, "kernel_launch: hipFuncSetAttribute failed\n");
        if (hipOccupancyMaxActiveBlocksPerMultiprocessor(&per_cu, (const void*)fwd_mega, NT, LDS_BYTES) != hipSuccess || per_cu < 1) { fprintf(stderr, "kernel_launch: occupancy query gave %d\n", per_cu); per_cu = 1; }
        (void)hipGetLastError();
        if (cus <= 0) cus = 256;
        grid = cus * per_cu;
        fprintf(stderr, "kernel_launch: grid %d (cus %d per_cu %d) ws %zu\n", grid, cus, per_cu, ws_size);
    }
    Args a{};
    a.xp = (const float*)d_in[0]; a.xs = (const float*)d_in[1]; a.g_mix = (const float*)d_in[2]; a.w_in = (const float*)d_in[3]; a.g_q = (const float*)d_in[4]; a.g_k = (const float*)d_in[5];
    a.sink = (const float*)d_in[6]; a.g_v_ln = (const float*)d_in[7]; a.b_v_ln = (const float*)d_in[8]; a.w_sp = (const float*)d_in[9]; a.b_sp = (const float*)d_in[10];
    a.g_ao = (const float*)d_in[11]; a.g_go = (const float*)d_in[12]; a.w_out = (const float*)d_in[13]; a.g_ffn = (const float*)d_in[14]; a.w_up = (const float*)d_in[15]; a.w_down = (const float*)d_in[16];
    a.out = (float*)d_out; a.ws = (unsigned char*)d_ws;
    void* args[] = {&a};
    hipError_t e = hipLaunchCooperativeKernel((const void*)fwd_mega, dim3(grid), dim3(NT), args, LDS_BYTES, stream);
    if (e != hipSuccess) fprintf(stderr, "kernel_launch: cooperative launch failed: %s (grid %d)\n", hipGetErrorString(e), grid);
}
```

```cpp
#include <hip/hip_runtime.h>
#include <hip/hip_cooperative_groups.h>
#include <cstdio>
#include <cstdint>
namespace cg = cooperative_groups;
namespace pg8 {
#define PG8_LAS __attribute__((address_space(3)))
typedef unsigned short bf16_t;
typedef short bf16x8 __attribute__((ext_vector_type(8)));
typedef float f32x4 __attribute__((ext_vector_type(4)));
typedef unsigned u32x4 __attribute__((ext_vector_type(4)));
constexpr int BM = 256, BK = 64, HALF = 128, HTB = HALF * BK * 2  , STAGE_BYTES = 8 * HTB, NXCD = 8, WGM = 8;

__host__ __device__ __forceinline__ int lds_byte(int r, int c) { const int st = (r >> 4) * 2 + (c >> 5), rr = r & 15, cc = c & 31, ob = rr * 64 + cc * 2; return st * 1024 + (ob ^ (((ob >> 9) & 1) << 5)); }
__host__ __device__ __forceinline__ void stage_rc(int b, int& R, int& C) { const int st = b / 1024, sb = b % 1024, swz = sb ^ (((sb >> 9) & 1) << 5); R = (st >> 1) * 16 + swz / 64; C = (st & 1) * 32 + (swz % 64) / 2; }
__host__ __device__ __forceinline__ int perm32(int rho) { const int n = rho >> 4, i = rho & 15; return 8 * (i >> 2) + 4 * n + (i & 3); }

struct Unit { int pm, pn, kh, slot; };
struct Gemm { const bf16_t* A; const bf16_t* Bt; int M, N, K, ld; };

struct StaticOrder {
    int nM, nN, nwg, G, c, wgm;
    __host__ __device__ void init(int M, int N, int G_, int c_, int wgm_ = WGM) { nM = M / BM; nN = N / BM; nwg = nM * nN; G = G_; c = c_; wgm = wgm_; }
    __host__ __device__ bool next(int i, Unit& u) const {
        const long L = (long)i * G + c; if (L >= nwg) return false;
        int wgid = (int)L; { const int q = nwg / NXCD, r = nwg % NXCD, xcd = wgid % NXCD, off = wgid / NXCD; wgid = (xcd < r ? xcd * (q + 1) : r * (q + 1) + (xcd - r) * q) + off; }
        const int nig = wgm * nN, gid = wgid / nig, fm = gid * wgm, gsz = (nM - fm) < wgm ? (nM - fm) : wgm;
        u.pm = fm + ((wgid % nig) % gsz); u.pn = (wgid % nig) / gsz; u.kh = 0; u.slot = i; return true;
    }
    __device__ __forceinline__ void a_ready(const Unit&) const {}
    __device__ __forceinline__ void done(const Unit&) const {}
};
__device__ __forceinline__ unsigned cvt_pk_bf16(float lo, float hi) { unsigned r; asm volatile("v_cvt_pk_bf16_f32 %0, %1, %2" : "=v"(r) : "v"(lo), "v"(hi)); return r; }
struct SplitOrder : StaticOrder {
    __host__ __device__ bool next(int i, Unit& u) const { if (!StaticOrder::next(i >> 1, u)) return false; u.kh = i & 1; u.slot = i >> 1; return true; }
};
typedef float f32x2 __attribute__((ext_vector_type(2)));
typedef unsigned u32x2 __attribute__((ext_vector_type(2)));
__device__ __forceinline__ float gelu_tanh(float x) {
    const float t = x * x * 0.044715f + 1.0f;
    const float e = __builtin_amdgcn_exp2f(x * t * (-2.0f * 0.7978845608028654f * 1.4426950408889634f));
    return x * __builtin_amdgcn_rcpf(1.0f + e);
}
constexpr int PROJ_LD = 3584, DM = 2048, DFF = 8192;
constexpr float EPSN = 1e-6f;

struct EpiProj {
    static constexpr bool PERM = true, AFTER_DRAIN = false, MID = false, MIDLOOP = false;
    bf16_t* O; const float* r1; float* lnstat; const float* gq; const float* gk; const float* tab; PG8_LAS float* xch;
    __device__ __forceinline__ void operator()(const f32x4 (&acc)[2][2][4][2], const Unit& u, int wr, int wc, int fr, int fq) const {
        const int row0 = u.pm * BM + wr * 64 + fr, col0 = u.pn * BM + wc * 32 + 8 * fq;
        if (u.pn <= 4) {
            float rsv[2][4];
#pragma unroll
            for (int ai = 0; ai < 2; ++ai)
#pragma unroll
                for (int m = 0; m < 4; ++m) {
                    const float rs = r1[row0 + ai * HALF + m * 16]; rsv[ai][m] = rs;
#pragma unroll
                    for (int bj = 0; bj < 2; ++bj) {
                        const f32x4 v0 = acc[ai][bj][m][0] * rs, v1 = acc[ai][bj][m][1] * rs;
                        float s = (v0[0] * v0[0] + v0[1] * v0[1]) + (v0[2] * v0[2] + v0[3] * v0[3]) + (v1[0] * v1[0] + v1[1] * v1[1]) + (v1[2] * v1[2] + v1[3] * v1[3]);
                        s += __shfl_xor(s, 16); s += __shfl_xor(s, 32);
                        if (fq == 0) xch[((((wr * 4 + wc) * 2 + ai) * 4 + m) * 2 + bj) * 16 + fr] = s;
                    }
                }
            asm volatile("s_waitcnt lgkmcnt(0)" ::: "memory"); __builtin_amdgcn_s_barrier(); asm volatile("" ::: "memory");
            const bool isq = u.pn < 4; const float* gp = (isq ? gq : gk) + wc * 32 + 8 * fq;
            const f32x4 g0 = *(const f32x4*)gp, g1 = *(const f32x4*)(gp + 4);
            const float osc = isq ? 0.08838834764831845f * 1.4426950408889634f : 1.0f;
#pragma unroll
            for (int ai = 0; ai < 2; ++ai)
#pragma unroll
                for (int m = 0; m < 4; ++m) {
                    const int row = row0 + ai * HALF + m * 16; const float rs = rsv[ai][m];
                    bf16_t* rowp = O + (size_t)row * PROJ_LD + col0;
                    f32x4 c0 = {0.f, 0.f, 0.f, 0.f}, c1 = c0, c2 = c0, c3 = c0;
                    if (wc == 0) { const int pos = (row < 8192) ? (row & 4095) : (row & 2047); const f32x4* tp = (const f32x4*)(tab + ((size_t)pos * 16 + 8 * (fq & 1)) * 2); c0 = tp[0]; c1 = tp[1]; c2 = tp[2]; c3 = tp[3]; }
#pragma unroll
                    for (int bj = 0; bj < 2; ++bj) {
                        float tot = 0.f;
#pragma unroll
                        for (int w = 0; w < 4; ++w) tot += xch[((((wr * 4 + w) * 2 + ai) * 4 + m) * 2 + bj) * 16 + fr];
                        const float sc = rs * __builtin_amdgcn_rsqf(tot * (1.0f / 128.0f) + EPSN);
                        f32x4 v0 = acc[ai][bj][m][0] * sc * g0, v1 = acc[ai][bj][m][1] * sc * g1;
                        if (wc == 0) {
                            f32x4 p0, p1;
#pragma unroll
                            for (int j = 0; j < 4; ++j) { p0[j] = __shfl_xor(v0[j], 32); p1[j] = __shfl_xor(v1[j], 32); }
                            const float sg = (fq < 2) ? -1.0f : 1.0f;
                            v0[0] = v0[0] * c0[0] + sg * p0[0] * c0[1]; v0[1] = v0[1] * c0[2] + sg * p0[1] * c0[3]; v0[2] = v0[2] * c1[0] + sg * p0[2] * c1[1]; v0[3] = v0[3] * c1[2] + sg * p0[3] * c1[3];
                            v1[0] = v1[0] * c2[0] + sg * p1[0] * c2[1]; v1[1] = v1[1] * c2[2] + sg * p1[1] * c2[3]; v1[2] = v1[2] * c3[0] + sg * p1[2] * c3[1]; v1[3] = v1[3] * c3[2] + sg * p1[3] * c3[3];
                        }
                        v0 *= osc; v1 *= osc;
                        u32x4 w; w.x = cvt_pk_bf16(v0[0], v0[1]); w.y = cvt_pk_bf16(v0[2], v0[3]); w.z = cvt_pk_bf16(v1[0], v1[1]); w.w = cvt_pk_bf16(v1[2], v1[3]);
                        __builtin_nontemporal_store(w, (u32x4*)(rowp + bj * HALF));
                    }
                }
            return;
        }
        const bool act = u.pn >= 6, st = u.pn >= 10;
#pragma unroll
        for (int ai = 0; ai < 2; ++ai)
#pragma unroll
            for (int m = 0; m < 4; ++m) {
                const int row = row0 + ai * HALF + m * 16; const float rs = r1[row];
                bf16_t* rowp = O + (size_t)row * PROJ_LD + col0; float s1 = 0.f, s2 = 0.f;
#pragma unroll
                for (int bj = 0; bj < 2; ++bj) {
                    f32x4 v0 = acc[ai][bj][m][0] * rs, v1 = acc[ai][bj][m][1] * rs;
                    if (act) {
#pragma unroll
                        for (int j = 0; j < 4; ++j) { v0[j] = gelu_tanh(v0[j]); v1[j] = gelu_tanh(v1[j]); }
                    }
                    if (st) {
#pragma unroll
                        for (int j = 0; j < 4; ++j) { s1 += v0[j] + v1[j]; s2 += v0[j] * v0[j] + v1[j] * v1[j]; }
                    }
                    u32x4 w; w.x = cvt_pk_bf16(v0[0], v0[1]); w.y = cvt_pk_bf16(v0[2], v0[3]); w.z = cvt_pk_bf16(v1[0], v1[1]); w.w = cvt_pk_bf16(v1[2], v1[3]);
                    __builtin_nontemporal_store(w, (u32x4*)(rowp + bj * HALF));
                }
                if (st && lnstat) {
                    s1 += __shfl_xor(s1, 16); s1 += __shfl_xor(s1, 32); s2 += __shfl_xor(s2, 16); s2 += __shfl_xor(s2, 32);
                    if (fq == 0) { unsafeAtomicAdd(lnstat + 2 * row, s1); unsafeAtomicAdd(lnstat + 2 * row + 1, s2); }
                }
            }
    }
};
struct EpiOut {
    static constexpr bool PERM = false, AFTER_DRAIN = false, MID = false, MIDLOOP = true;
    bf16_t* x1b; float* ss2; const PG8_LAS f32x2* sct;
    __device__ __forceinline__ void midloop(f32x4 (&acc)[2][2][4][2], const Unit& u, int wr, int fr) const {
        const PG8_LAS f32x2* p = sct + u.slot * 256 + wr * 64 + fr;
#pragma unroll
        for (int ai = 0; ai < 2; ++ai)
#pragma unroll
            for (int m = 0; m < 4; ++m) {
                const float ratio = p[ai * HALF + m * 16][0];
#pragma unroll
                for (int bj = 0; bj < 2; ++bj)
#pragma unroll
                    for (int n = 0; n < 2; ++n) acc[ai][bj][m][n] *= ratio;
            }
    }
    __device__ __forceinline__ void operator()(const f32x4 (&acc)[2][2][4][2], const Unit& u, int wr, int wc, int fr, int fq) const {
        const int row0 = u.pm * BM + wr * 64 + fr, col0 = u.pn * BM + wc * 32 + 4 * fq;
        const PG8_LAS f32x2* p = sct + u.slot * 256 + wr * 64 + fr;
#pragma unroll
        for (int ai = 0; ai < 2; ++ai)
#pragma unroll
            for (int m = 0; m < 4; ++m) {
                const int row = row0 + ai * HALF + m * 16; const float rg = p[ai * HALF + m * 16][1];
                bf16_t* brow = x1b + (size_t)row * DM + col0; float sq = 0.f;
#pragma unroll
                for (int bj = 0; bj < 2; ++bj)
#pragma unroll
                    for (int n = 0; n < 2; ++n) {
                        const u32x2 xw = *(const u32x2*)(brow + bj * HALF + n * 16);
                        f32x4 v = acc[ai][bj][m][n] * rg;
                        v[0] += __builtin_bit_cast(float, xw.x << 16); v[1] += __builtin_bit_cast(float, xw.x & 0xffff0000u); v[2] += __builtin_bit_cast(float, xw.y << 16); v[3] += __builtin_bit_cast(float, xw.y & 0xffff0000u);
                        u32x2 w; w.x = cvt_pk_bf16(v[0], v[1]); w.y = cvt_pk_bf16(v[2], v[3]); *(u32x2*)(brow + bj * HALF + n * 16) = w;
                        sq += (v[0] * v[0] + v[1] * v[1]) + (v[2] * v[2] + v[3] * v[3]);
                    }
                sq += __shfl_xor(sq, 16); sq += __shfl_xor(sq, 32);
                if (fq == 0) unsafeAtomicAdd(ss2 + row, sq);
            }
    }
};
struct EpiUp {
    static constexpr bool PERM = true, AFTER_DRAIN = false, MID = false, MIDLOOP = false;
    bf16_t* H; const float* ss2;
    __device__ __forceinline__ void operator()(const f32x4 (&acc)[2][2][4][2], const Unit& u, int wr, int wc, int fr, int fq) const {
        const int row0 = u.pm * BM + wr * 64 + fr, col0 = u.pn * BM + wc * 32 + 8 * fq;
#pragma unroll
        for (int ai = 0; ai < 2; ++ai)
#pragma unroll
            for (int m = 0; m < 4; ++m) {
                const int row = row0 + ai * HALF + m * 16; const float rs = 1.0f / sqrtf(ss2[row] * (1.0f / 2048.0f) + EPSN);
                bf16_t* rowp = H + (size_t)row * DFF + col0;
#pragma unroll
                for (int bj = 0; bj < 2; ++bj) {
                    f32x4 v0 = acc[ai][bj][m][0] * rs, v1 = acc[ai][bj][m][1] * rs;
#pragma unroll
                    for (int j = 0; j < 4; ++j) { v0[j] = fmaxf(v0[j], 0.f); v0[j] *= v0[j]; v1[j] = fmaxf(v1[j], 0.f); v1[j] *= v1[j]; }
                    u32x4 w; w.x = cvt_pk_bf16(v0[0], v0[1]); w.y = cvt_pk_bf16(v0[2], v0[3]); w.z = cvt_pk_bf16(v1[0], v1[1]); w.w = cvt_pk_bf16(v1[2], v1[3]);
                    *(u32x4*)(rowp + bj * HALF) = w;
                }
            }
    }
};
struct EpiDown {
    static constexpr bool PERM = false, AFTER_DRAIN = false, MID = false, MIDLOOP = false;
    float* out; const bf16_t* x1b;
    __device__ __forceinline__ void operator()(const f32x4 (&acc)[2][2][4][2], const Unit& u, int wr, int wc, int fr, int fq) const {
        const int row0 = u.pm * BM + wr * 64 + fr, col0 = u.pn * BM + wc * 32 + 4 * fq;
#pragma unroll
        for (int ai = 0; ai < 2; ++ai)
#pragma unroll
            for (int m = 0; m < 4; ++m) {
                const size_t off = (size_t)(row0 + ai * HALF + m * 16) * DM + col0;
#pragma unroll
                for (int bj = 0; bj < 2; ++bj)
#pragma unroll
                    for (int n = 0; n < 2; ++n) { const u32x2 xw = *(const u32x2*)(x1b + off + bj * HALF + n * 16); f32x4 v = acc[ai][bj][m][n];
                        v[0] += __builtin_bit_cast(float, xw.x << 16); v[1] += __builtin_bit_cast(float, xw.x & 0xffff0000u); v[2] += __builtin_bit_cast(float, xw.y << 16); v[3] += __builtin_bit_cast(float, xw.y & 0xffff0000u);
                        __builtin_nontemporal_store(v, (f32x4*)(out + off + bj * HALF + n * 16)); }
            }
    }
};

template <class Epi, class Sched, bool ALIGN_EPI = false, bool SP2 = false>
__device__ __forceinline__ void gemm_phase(PG8_LAS unsigned char* lds, const Gemm g, const Sched& S, const Epi& E) {
    int tid_ = threadIdx.x; asm volatile("" : "+v"(tid_));
    const int tid = tid_, wid = __builtin_amdgcn_readfirstlane(tid >> 6), lane = tid & 63, wr = wid >> 2, wc = wid & 3, fr = lane & 15, fq = lane >> 4;
    const int K = g.K, nt = K / BK, LD = g.ld;
    unsigned voffA[2], voffB[2];
#pragma unroll
    for (int i = 0; i < 2; ++i) { int R, C; stage_rc(tid * 16 + i * 8192, R, C); const int Rb = Epi::PERM ? ((R & ~31) + perm32(R & 31)) : R;
        voffA[i] = (unsigned)(R * LD + C) * 2u; voffB[i] = (unsigned)(Rb * LD + C) * 2u; }
    const size_t kstep = (size_t)(BK * 2);
    const size_t hstep = (size_t)HALF * LD * 2;
    const size_t tstep = 2 * hstep;
    const unsigned ldsw = (unsigned)wid * 1024u;
    const int aoff = lds_byte(wr * 64 + fr, fq * 8), boff = lds_byte(wc * 32 + fr, fq * 8);
#define PG8_SA(b, h) (((b) * 2 + (h)) * HTB)
#define PG8_SB(b, h) ((4 + (b) * 2 + (h)) * HTB)
#define PG8_STAGE(bufoff, gbase, voff) do { _Pragma("unroll") for (int _i = 0; _i < 2; ++_i) \
        __builtin_amdgcn_global_load_lds((const unsigned*)((const char*)(gbase) + (voff)[_i]), (PG8_LAS unsigned*)(lds + (bufoff) + ldsw + _i * 8192), 16, 0, 0); } while (0)
#define PG8_LDA(dst, b, h) do { _Pragma("unroll") for (int m = 0; m < 4; ++m) _Pragma("unroll") for (int k = 0; k < 2; ++k) dst[m][k] = *(const PG8_LAS bf16x8*)(lds + PG8_SA(b, h) + aoff + m * 2048 + k * 1024); } while (0)
#define PG8_LDB(dst, b, h) do { _Pragma("unroll") for (int n = 0; n < 2; ++n) _Pragma("unroll") for (int k = 0; k < 2; ++k) dst[n][k] = *(const PG8_LAS bf16x8*)(lds + PG8_SB(b, h) + boff + n * 2048 + k * 1024); } while (0)
#define PG8_MMA(ai, bj, At, Bt) do { __builtin_amdgcn_s_setprio(1); _Pragma("unroll") for (int m = 0; m < 4; ++m) _Pragma("unroll") for (int n = 0; n < 2; ++n) _Pragma("unroll") for (int k = 0; k < 2; ++k) \
        acc[ai][bj][m][n] = __builtin_amdgcn_mfma_f32_16x16x32_bf16(Bt[n][k], At[m][k], acc[ai][bj][m][n], 0, 0, 0); __builtin_amdgcn_s_setprio(0); } while (0)
#define PG8_WAIT_V(n) asm volatile("s_waitcnt vmcnt(" #n ")" ::: "memory")
#define PG8_WAIT_L(n) asm volatile("s_waitcnt lgkmcnt(" #n ")" ::: "memory")
#define PG8_BAR __builtin_amdgcn_s_barrier()
#define PG8_SCHED __builtin_amdgcn_sched_barrier(0)
    Unit cur, nxt; int ui = 0;
    if (!S.next(0, cur)) return;
    f32x4 acc[2][2][4][2];
#pragma unroll
    for (int a = 0; a < 2; ++a)
#pragma unroll
        for (int b = 0; b < 2; ++b)
#pragma unroll
            for (int m = 0; m < 4; ++m)
#pragma unroll
                for (int n = 0; n < 2; ++n) acc[a][b][m][n] = (f32x4){0.f, 0.f, 0.f, 0.f};
    bf16x8 At[4][2], B0[2][2], B1[2][2];
    const size_t khstep = (size_t)K * 2;
    const char* cA = (const char*)g.A + (size_t)cur.pm * tstep + cur.kh * khstep; const char* cB = (const char*)g.Bt + (size_t)cur.pn * tstep + cur.kh * khstep;
    S.a_ready(cur);
    if constexpr (SP2) {
        PG8_STAGE(PG8_SB(0, 0), cB, voffB); PG8_STAGE(PG8_SB(0, 1), cB + hstep, voffB); PG8_STAGE(PG8_SA(0, 0), cA, voffA); PG8_STAGE(PG8_SA(0, 1), cA + hstep, voffA);
        if (wr == 1) PG8_BAR;
        PG8_WAIT_V(2); PG8_BAR;
        PG8_STAGE(PG8_SB(1, 0), cB + kstep, voffB); PG8_STAGE(PG8_SA(1, 0), cA + kstep, voffA); PG8_STAGE(PG8_SB(1, 1), cB + hstep + kstep, voffB);
        PG8_WAIT_V(6); PG8_BAR;
    } else {
        PG8_STAGE(PG8_SB(0, 0), cB, voffB); PG8_STAGE(PG8_SA(0, 0), cA, voffA); PG8_STAGE(PG8_SB(0, 1), cB + hstep, voffB); PG8_STAGE(PG8_SA(0, 1), cA + hstep, voffA);
        if (wr == 1) PG8_BAR;
        PG8_WAIT_V(4); PG8_BAR;
        PG8_STAGE(PG8_SB(1, 0), cB + kstep, voffB); PG8_STAGE(PG8_SA(1, 0), cA + kstep, voffA); PG8_STAGE(PG8_SB(1, 1), cB + hstep + kstep, voffB);
        PG8_WAIT_V(6); PG8_BAR;
    }
    for (;;) {
        const bool has_next = S.next(ui + 1, nxt);
        const char* nA = has_next ? (const char*)g.A + (size_t)nxt.pm * tstep + nxt.kh * khstep : cA; const char* nB = has_next ? (const char*)g.Bt + (size_t)nxt.pn * tstep + nxt.kh * khstep : cB;
        for (int t = 0; t < nt; t += 2) {
            const bool last = (t == nt - 2);
            const char* a1 = cA + (size_t)(t + 1) * kstep;
            const char* a2 = last ? nA : cA + (size_t)(t + 2) * kstep; const char* b2 = last ? nB : cB + (size_t)(t + 2) * kstep;
            const char* a3 = a2 + kstep; const char* b3 = b2 + kstep;
            if (last && has_next) S.a_ready(nxt);
            if constexpr (Epi::MIDLOOP) { if (t == (nt >> 1)) E.midloop(acc, cur, wr, fr); }
            if constexpr (SP2) {
            PG8_LDB(B0, 0, 0); PG8_LDB(B1, 0, 1); PG8_SCHED; PG8_LDA(At, 0, 0); PG8_STAGE(PG8_SA(1, 1), a1 + hstep, voffA);
            PG8_WAIT_V(8); PG8_WAIT_L(0); PG8_BAR; PG8_MMA(0, 0, At, B0); PG8_MMA(0, 1, At, B1); PG8_BAR; PG8_SCHED;
            PG8_LDA(At, 0, 1); PG8_STAGE(PG8_SB(0, 0), b2, voffB); PG8_STAGE(PG8_SB(0, 1), b2 + hstep, voffB); PG8_STAGE(PG8_SA(0, 0), a2, voffA);
            PG8_WAIT_V(8); PG8_WAIT_L(0); PG8_BAR; PG8_MMA(1, 0, At, B0); PG8_MMA(1, 1, At, B1); PG8_BAR; PG8_SCHED;
            PG8_LDB(B0, 1, 0); PG8_LDB(B1, 1, 1); PG8_SCHED; PG8_LDA(At, 1, 0); PG8_STAGE(PG8_SA(0, 1), a2 + hstep, voffA);
            PG8_WAIT_V(8); PG8_WAIT_L(0); PG8_BAR; PG8_MMA(0, 0, At, B0); PG8_MMA(0, 1, At, B1); PG8_BAR; PG8_SCHED;
            PG8_LDA(At, 1, 1); PG8_STAGE(PG8_SB(1, 0), b3, voffB); PG8_STAGE(PG8_SB(1, 1), b3 + hstep, voffB); PG8_STAGE(PG8_SA(1, 0), a3, voffA);
            PG8_WAIT_V(8); PG8_WAIT_L(0); PG8_BAR; PG8_MMA(1, 0, At, B0); PG8_MMA(1, 1, At, B1); PG8_BAR; PG8_SCHED;
            } else {
            PG8_LDB(B0, 0, 0); PG8_SCHED; PG8_LDA(At, 0, 0); PG8_STAGE(PG8_SA(1, 1), a1 + hstep, voffA);
            PG8_WAIT_L(8); PG8_BAR; PG8_WAIT_L(0); PG8_MMA(0, 0, At, B0); PG8_BAR; PG8_SCHED;
            PG8_LDB(B1, 0, 1); PG8_STAGE(PG8_SB(0, 0), b2, voffB);
            PG8_BAR; PG8_WAIT_L(0); PG8_MMA(0, 1, At, B1); PG8_BAR;
            PG8_LDA(At, 0, 1); PG8_STAGE(PG8_SA(0, 0), a2, voffA);
            PG8_BAR; PG8_WAIT_L(0); PG8_MMA(1, 0, At, B0); PG8_BAR; PG8_SCHED;
            PG8_STAGE(PG8_SB(0, 1), b2 + hstep, voffB);
            PG8_WAIT_V(6); PG8_BAR; PG8_MMA(1, 1, At, B1); PG8_BAR;
            PG8_LDB(B0, 1, 0); PG8_SCHED; PG8_LDA(At, 1, 0); PG8_STAGE(PG8_SA(0, 1), a2 + hstep, voffA);
            PG8_WAIT_L(8); PG8_BAR; PG8_WAIT_L(0); PG8_MMA(0, 0, At, B0); PG8_BAR; PG8_SCHED;
            PG8_LDB(B1, 1, 1); PG8_STAGE(PG8_SB(1, 0), b3, voffB);
            PG8_BAR; PG8_WAIT_L(0); PG8_MMA(0, 1, At, B1); PG8_BAR;
            PG8_LDA(At, 1, 1); PG8_STAGE(PG8_SA(1, 0), a3, voffA);
            PG8_BAR; PG8_WAIT_L(0); PG8_MMA(1, 0, At, B0); PG8_BAR; PG8_SCHED;
            PG8_STAGE(PG8_SB(1, 1), b3 + hstep, voffB);
            PG8_WAIT_V(6); PG8_BAR; PG8_MMA(1, 1, At, B1); PG8_BAR;
            }
        }
        if constexpr (ALIGN_EPI) { if (wr == 0) PG8_BAR; }
        bool keep = false;
        if constexpr (Epi::MID) { if (cur.kh == 0) { E.mid(acc, cur, wr, wc, fr, fq); keep = true; } else E(acc, cur, wr, wc, fr, fq); }
        else if constexpr (!Epi::AFTER_DRAIN) { E(acc, cur, wr, wc, fr, fq); S.done(cur); }
        if (!has_next) break;
        if (!keep) {
#pragma unroll
        for (int a = 0; a < 2; ++a)
#pragma unroll
            for (int b = 0; b < 2; ++b)
#pragma unroll
                for (int m = 0; m < 4; ++m)
#pragma unroll
                    for (int n = 0; n < 2; ++n) acc[a][b][m][n] = (f32x4){0.f, 0.f, 0.f, 0.f};
        }
        cur = nxt; cA = nA; cB = nB; ++ui;
        if constexpr (ALIGN_EPI) { if (wr == 1) PG8_BAR; }
    }
    PG8_WAIT_V(0);
    if constexpr (!ALIGN_EPI) { if (wr == 0) PG8_BAR; }
    PG8_BAR;
    if constexpr (Epi::AFTER_DRAIN) { E.fused(acc, cur, wr, wc, fr, fq, lds, wid, lane); S.done(cur); }
#undef PG8_SA
#undef PG8_SB
#undef PG8_STAGE
#undef PG8_LDA
#undef PG8_LDB
#undef PG8_MMA
#undef PG8_WAIT_V
#undef PG8_WAIT_L
#undef PG8_BAR
#undef PG8_SCHED
}
}

#define LAS __attribute__((address_space(3)))
typedef unsigned short bf16;
typedef float f32x4 __attribute__((ext_vector_type(4)));
typedef short bf16x8 __attribute__((ext_vector_type(8)));
typedef short s16x4 __attribute__((ext_vector_type(4)));
typedef unsigned v4u __attribute__((ext_vector_type(4)));
typedef unsigned v2u __attribute__((ext_vector_type(2)));
typedef float f32x2 __attribute__((ext_vector_type(2)));
constexpr int NW = 8, NT = 512;
constexpr int T = 16384, D = 2048, INW = 3584, FF = 8192, TH = 8192;
constexpr int LDS_BYTES = 147456, LDS_BARST = LDS_BYTES - 64;
constexpr size_t MiB = 1u << 20;
constexpr size_t WS_BAR = 2 * MiB + 65536  , WS_PAR = 2 * MiB, WS_LNSTAT = 0, WS_SS2 = 131072, WS_R1 = 196608, WS_SSMIX = 262144, WS_TAB = 1310720, WS_WSP = 1835008;
constexpr size_t WS_WIN = 3 * MiB, WS_WOUT = 17 * MiB, WS_WUP = 25 * MiB, WS_WDOWN = 57 * MiB, WS_XB = 89 * MiB, WS_HID = 153 * MiB, WS_MIX = 153 * MiB, WS_END = 281 * MiB;
constexpr int PAR_GQ = 0, PAR_GK = 128, PAR_SINK = 256, PAR_GV = 512, PAR_BV = 1536, PAR_BSP = 2560, PAR_N = 3584;
constexpr int C_Q = 0, C_K = 1024, C_V = 1280, C_U = 1536, C_VG = 2560;
constexpr int QK_STRIDE = 272, V_STRIDE = 288;
constexpr int LQ = 0, LK = 2 * 128 * QK_STRIDE, LV = LK + 128 * QK_STRIDE;
static_assert(LV + 128 * V_STRIDE <= LDS_BYTES, "attention LDS");
constexpr float LOG2E = 1.4426950408889634f;

__device__ __forceinline__ unsigned f2bf(float f) { unsigned u = __builtin_bit_cast(unsigned, f); return (u + 0x7fffu + ((u >> 16) & 1u)) >> 16; }
__device__ __forceinline__ unsigned pk2(float lo, float hi) { return pg8::cvt_pk_bf16(lo, hi); }
__device__ __forceinline__ float bflo(unsigned w) { return __builtin_bit_cast(float, w << 16); }
__device__ __forceinline__ float bfhi(unsigned w) { return __builtin_bit_cast(float, w & 0xffff0000u); }
__device__ __forceinline__ float wave_sum(float v) {
#pragma unroll
    for (int o = 1; o < 64; o <<= 1) v += __shfl_xor(v, o);
    return v;
}
#define LDS_WAIT() asm volatile("s_waitcnt lgkmcnt(0)" ::: "memory")

#define RLX_AGENT __ATOMIC_RELAXED, __HIP_MEMORY_SCOPE_AGENT
#define XB_TMO      128
#define XB_XCNT(j)  (256  + 64 * (j))
#define XB_XSUB(j)  (1280 + 64 * (j))
#define XB_XGEN(j)  (2304 + 64 * (j))
#define XB_TOP      3328
#define XB_TOPGEN   3392
#define XCD_BAR_WORDS 3456
#define XB_SPIN_CAP (1u << 18)

__device__ __forceinline__ unsigned xb_ld(unsigned* p)              { return __hip_atomic_load(p, __ATOMIC_RELAXED, __HIP_MEMORY_SCOPE_AGENT); }
__device__ __forceinline__ unsigned xb_add(unsigned* p, unsigned v) { return __hip_atomic_fetch_add(p, v, __ATOMIC_RELAXED, __HIP_MEMORY_SCOPE_AGENT); }
__device__ __forceinline__ unsigned xb_xcc_id() { return (unsigned)__builtin_amdgcn_s_getreg((3 << 11) | 20) & 0xFu; }
#define XB_SPIN(cond, bar) do { unsigned _sp = 0; while (cond) { __builtin_amdgcn_s_sleep(1); \
    if ((++_sp & 255u) == 0u) { if (xb_ld(&(bar)[XB_TMO])) break; if (_sp > XB_SPIN_CAP) { atomicAdd(&(bar)[XB_TMO], 1u); break; } } } } while (0)

struct XcdBarrier {
    unsigned* bar; unsigned x;
    volatile LAS unsigned* st;
};

__device__ __forceinline__ XcdBarrier xcd_barrier_post(unsigned* bar, volatile LAS unsigned* st) {
    XcdBarrier b; b.bar = bar; b.x = xb_xcc_id(); b.st = st;
    if (threadIdx.x == 0) (void)xb_add(&bar[XB_XCNT(b.x)], 1u);
    return b;
}
__device__ __forceinline__ void xcd_barrier_complete(unsigned* bar, unsigned x, unsigned& nloc, unsigned& nx) {
    const unsigned G = gridDim.x * gridDim.y * gridDim.z;
    unsigned sum, cnt, mine, sp = 0u;
    for (;;) {
        sum = 0u; cnt = 0u; mine = 0u;
#pragma unroll
        for (unsigned j = 0; j < 16; ++j) { const unsigned c = xb_ld(&bar[XB_XCNT(j)]); sum += c; cnt += (c > 0u) ? 1u : 0u; mine = (j == x) ? c : mine; }
        if (sum == G) break;
        __builtin_amdgcn_s_sleep(1);
        if ((++sp & 255u) == 0u) { if (xb_ld(&bar[XB_TMO])) break; if (sp > XB_SPIN_CAP) { atomicAdd(&bar[XB_TMO], 1u); break; } }
    }
    nloc = mine > 0u ? mine : 1u; nx = cnt > 0u ? cnt : 1u;
}

__device__ __forceinline__ void xcd_barrier(const XcdBarrier& b) {
    asm volatile("s_waitcnt vmcnt(0)" ::: "memory");
    __syncthreads();
    if (threadIdx.x == 0) {
        unsigned* bar = b.bar;
        __builtin_amdgcn_s_waitcnt(0);
        unsigned nloc = b.st[0], nx = b.st[1];
        if (nloc == 0u) { xcd_barrier_complete(bar, b.x, nloc, nx); b.st[0] = nloc; b.st[1] = nx; }
        const unsigned old = xb_add(&bar[XB_XSUB(b.x)], 1u);
        const unsigned gen = old / nloc;
        if (old + 1u == (gen + 1u) * nloc) {
            __builtin_amdgcn_fence(__ATOMIC_RELEASE, "agent");
            asm volatile("s_waitcnt vmcnt(0)" ::: "memory");
            const unsigned og = xb_add(&bar[XB_TOP], 1u);
            const unsigned tg = og / nx;
            if (og + 1u == (tg + 1u) * nx) xb_add(&bar[XB_TOPGEN], 1u);
            else XB_SPIN(xb_ld(&bar[XB_TOPGEN]) == tg, bar);
            __builtin_amdgcn_fence(__ATOMIC_ACQUIRE, "agent");
            xb_add(&bar[XB_XGEN(b.x)], 1u);
            asm volatile("s_waitcnt vmcnt(0)" ::: "memory");
        } else {
            XB_SPIN(xb_ld(&bar[XB_XGEN(b.x)]) == gen, bar);
            __builtin_amdgcn_fence(__ATOMIC_ACQUIRE, "agent");
            asm volatile("s_waitcnt vmcnt(0)" ::: "memory");
        }
    }
    __syncthreads();
}


struct Args {
    const float *xp, *xs, *g_mix, *w_in, *g_q, *g_k, *sink, *g_v_ln, *b_v_ln, *w_sp, *b_sp, *g_ao, *g_go, *w_out, *g_ffn, *w_up, *w_down;
    float* out; unsigned char* ws;
};

__device__ __forceinline__ void transpose_tile(const float* __restrict__ W, int K, int N, bf16* __restrict__ WT, const float* __restrict__ ga, const float* __restrict__ gb, int gsplit, LAS float* scr, int item, int lane) {
    const int nkb = K / 64, nb = item / nkb, kb = item % nkb, k0 = 64 * kb, n0 = 64 * nb;
    const int c = lane & 15, kq = lane >> 4;
    f32x4 v[16];
#pragma unroll
    for (int i = 0; i < 16; ++i) v[i] = __builtin_nontemporal_load((const f32x4*)(W + (size_t)(k0 + 4 * i + kq) * N + n0 + 4 * c));
#pragma unroll
    for (int i = 0; i < 16; ++i) {
        const int k = k0 + 4 * i + kq; float g = 1.0f; if (ga) g = (k < gsplit) ? ga[k] : gb[k - gsplit];
        LAS float* p = scr + (4 * i + kq) * 65 + 4 * c; p[0] = v[i][0] * g; p[1] = v[i][1] * g; p[2] = v[i][2] * g; p[3] = v[i][3] * g;
    }
    LDS_WAIT(); asm volatile("" ::: "memory");
    const int kc = lane & 7;
#pragma unroll
    for (int j = 0; j < 8; ++j) { const int n = (lane >> 3) + 8 * j; const LAS float* sp = scr + (8 * kc) * 65 + n;
        v4u o; o.x = pk2(sp[0 * 65], sp[1 * 65]); o.y = pk2(sp[2 * 65], sp[3 * 65]); o.z = pk2(sp[4 * 65], sp[5 * 65]); o.w = pk2(sp[6 * 65], sp[7 * 65]);
        *(v4u*)(WT + (size_t)(n0 + n) * K + k0 + 8 * kc) = o; }
    LDS_WAIT(); asm volatile("" ::: "memory");
}

__device__ __forceinline__ bf16x8 tr_frag(const LAS unsigned char* p0, const LAS unsigned char* p1) {
    const s16x4 a = __builtin_amdgcn_ds_read_tr16_b64_v4i16((LAS s16x4*)p0);
    const s16x4 b = __builtin_amdgcn_ds_read_tr16_b64_v4i16((LAS s16x4*)p1);
    return __builtin_shufflevector(a, b, 0, 1, 2, 3, 4, 5, 6, 7);
}
__device__ __forceinline__ void tile_ld(v4u (&raw)[4], const bf16* proj, int tok0, int colbase, int tid) {
    const int c = tid & 15, r0 = tid >> 4;
#pragma unroll
    for (int p = 0; p < 4; ++p) raw[p] = *(const v4u*)(proj + (size_t)(tok0 + r0 + 32 * p) * INW + colbase + 8 * c);
}
template <int STRIDE> __device__ __forceinline__ void tile_st(const v4u (&raw)[4], LAS unsigned char* dst, int tid) {
    const int c = tid & 15, r0 = tid >> 4;
#pragma unroll
    for (int p = 0; p < 4; ++p) *(LAS v4u*)(dst + (r0 + 32 * p) * STRIDE + c * 16) = raw[p];
}

__device__ __forceinline__ void attn_unit(const bf16* proj, unsigned char* ws, LAS unsigned char* lds, int a) {
    int tid = threadIdx.x; asm volatile("" : "+v"(tid)); const int lane = tid & 63, wave = __builtin_amdgcn_readfirstlane(tid >> 6);
    const float* par = (const float*)(ws + WS_PAR);
    bf16* mix = (bf16*)(ws + WS_MIX); float* ssmix = (float*)(ws + WS_SSMIX);
    const int gb = a >> 2, kvh = (a >> 1) & 1, hp = a & 1;
    int n, nb; if (gb < 64) { nb = 32; n = gb & 31; } else { nb = 16; n = (gb - 64) & 15; }
    const int tok0 = gb * 128, hw = wave >> 2, rq = wave & 3, fr = lane & 15, fq = lane >> 4;
    const int h0 = kvh * 4 + hp * 2, h = h0 + hw;
    LAS unsigned char* QS = lds + LQ; LAS unsigned char* KS = lds + LK; LAS unsigned char* VS = lds + LV;
    const int kb0 = (n > 0) ? n - 1 : 0, kb1 = (n + 1 < nb) ? n + 1 : nb - 1;
    v4u kr[4], vr[4];
    {
        v4u q0[4], q1[4];
        tile_ld(q0, proj, tok0, C_Q + h0 * 128, tid); tile_ld(q1, proj, tok0, C_Q + (h0 + 1) * 128, tid);
        tile_ld(kr, proj, tok0 + (kb0 - n) * 128, C_K + kvh * 128, tid); tile_ld(vr, proj, tok0 + (kb0 - n) * 128, C_V + kvh * 128, tid);
        __syncthreads();
        tile_st<QK_STRIDE>(q0, QS, tid); tile_st<QK_STRIDE>(q1, QS + 128 * QK_STRIDE, tid);
    }
    const LAS unsigned char* qbase = QS + hw * (128 * QK_STRIDE) + (rq * 32 + fr) * QK_STRIDE + (8 * fq) * 2;
    const float sk2 = par[PAR_SINK + h] * LOG2E;
    float mrow[2], lrow[2]; mrow[0] = mrow[1] = sk2; lrow[0] = lrow[1] = (fq == 0) ? 1.0f : 0.0f;
    f32x4 O[2][8];
#pragma unroll
    for (int rt = 0; rt < 2; ++rt)
#pragma unroll
        for (int dt = 0; dt < 8; ++dt) O[rt][dt] = (f32x4){0.f, 0.f, 0.f, 0.f};
#pragma unroll 1
    for (int kb = kb0; kb <= kb1; ++kb) {
        if (kb != kb0) __syncthreads();
        tile_st<QK_STRIDE>(kr, KS, tid); tile_st<V_STRIDE>(vr, VS, tid);
        __syncthreads();
        if (kb < kb1) { tile_ld(kr, proj, tok0 + (kb + 1 - n) * 128, C_K + kvh * 128, tid); tile_ld(vr, proj, tok0 + (kb + 1 - n) * 128, C_V + kvh * 128, tid); }
        f32x4 st[2][8];
#pragma unroll
        for (int kt = 0; kt < 8; ++kt) { st[0][kt] = (f32x4){0.f, 0.f, 0.f, 0.f}; st[1][kt] = (f32x4){0.f, 0.f, 0.f, 0.f}; }
#pragma unroll
        for (int s = 0; s < 4; ++s) {
            const bf16x8 qa = *(const LAS bf16x8*)(qbase + 64 * s), qb = *(const LAS bf16x8*)(qbase + 16 * QK_STRIDE + 64 * s);
#pragma unroll
            for (int kt = 0; kt < 8; ++kt) {
                const bf16x8 kf = *(const LAS bf16x8*)(KS + (16 * kt + fr) * QK_STRIDE + (32 * s + 8 * fq) * 2);
                st[0][kt] = __builtin_amdgcn_mfma_f32_16x16x32_bf16(kf, qa, st[0][kt], 0, 0, 0);
                st[1][kt] = __builtin_amdgcn_mfma_f32_16x16x32_bf16(kf, qb, st[1][kt], 0, 0, 0);
            }
        }
        bf16x8 pb[2][4];
#pragma unroll
        for (int rt = 0; rt < 2; ++rt) {
            const int qi = rq * 32 + rt * 16 + fr;
            if (kb != n) {
                const int sgn = (kb < n) ? 1 : -1, dbase = sgn * (4 * fq - qi);
#pragma unroll
                for (int kt = 0; kt < 8; ++kt)
#pragma unroll
                    for (int r = 0; r < 4; ++r) { const int dd = dbase + sgn * (16 * kt + r); st[rt][kt][r] += __builtin_bit_cast(float, (unsigned)(dd >> 31) & 0xF149F2CAu); }
            }
            float mx = -1e30f;
#pragma unroll
            for (int kt = 0; kt < 8; ++kt)
#pragma unroll
                for (int r = 0; r < 4; ++r) mx = fmaxf(mx, st[rt][kt][r]);
            mx = fmaxf(mx, __shfl_xor(mx, 16)); mx = fmaxf(mx, __shfl_xor(mx, 32));
            const float mnew = fmaxf(mrow[rt], mx), alpha = __builtin_amdgcn_exp2f(mrow[rt] - mnew);
            mrow[rt] = mnew; float ls = lrow[rt] * alpha;
#pragma unroll
            for (int dt = 0; dt < 8; ++dt) O[rt][dt] *= alpha;
#pragma unroll
            for (int kt = 0; kt < 8; ++kt)
#pragma unroll
                for (int r = 0; r < 4; ++r) { const float p = __builtin_amdgcn_exp2f(st[rt][kt][r] - mnew); st[rt][kt][r] = p; ls += p; }
            lrow[rt] = ls;
#pragma unroll
            for (int tp = 0; tp < 4; ++tp) {
                v4u w; w.x = pk2(st[rt][2 * tp][0], st[rt][2 * tp][1]); w.y = pk2(st[rt][2 * tp][2], st[rt][2 * tp][3]);
                w.z = pk2(st[rt][2 * tp + 1][0], st[rt][2 * tp + 1][1]); w.w = pk2(st[rt][2 * tp + 1][2], st[rt][2 * tp + 1][3]);
                pb[rt][tp] = __builtin_bit_cast(bf16x8, w);
            }
        }
#pragma unroll
        for (int dt = 0; dt < 8; ++dt)
#pragma unroll
            for (int tp = 0; tp < 4; ++tp) {
                const LAS unsigned char* p0 = VS + (32 * tp + 4 * fq + (fr >> 2)) * V_STRIDE + (16 * dt + 4 * (fr & 3)) * 2;
                const bf16x8 vf = tr_frag(p0, p0 + 16 * V_STRIDE);
                O[0][dt] = __builtin_amdgcn_mfma_f32_16x16x32_bf16(vf, pb[0][tp], O[0][dt], 0, 0, 0);
                O[1][dt] = __builtin_amdgcn_mfma_f32_16x16x32_bf16(vf, pb[1][tp], O[1][dt], 0, 0, 0);
            }
    }
#pragma unroll
    for (int rt = 0; rt < 2; ++rt) {
        float lt = lrow[rt]; lt += __shfl_xor(lt, 16); lt += __shfl_xor(lt, 32);
        const float inv = 1.0f / lt; const int tok = tok0 + rq * 32 + rt * 16 + fr; float ss = 0.f;
        bf16* orow = mix + (size_t)tok * D + h * 128 + 4 * fq;
#pragma unroll
        for (int dt = 0; dt < 8; ++dt) { const f32x4 o = O[rt][dt] * inv; ss += (o[0] * o[0] + o[1] * o[1]) + (o[2] * o[2] + o[3] * o[3]);
            v2u w; w.x = pk2(o[0], o[1]); w.y = pk2(o[2], o[3]); *(v2u*)(orow + 16 * dt) = w; }
        ss += __shfl_xor(ss, 16); ss += __shfl_xor(ss, 32);
        if (fq == 0) unsafeAtomicAdd(ssmix + (size_t)tok * 2, ss);
    }
}

__device__ __forceinline__ void gmlp_unit(const bf16* proj, unsigned char* ws, LAS unsigned char* lds, int gu) {
    int tid = threadIdx.x; asm volatile("" : "+v"(tid)); const int lane = tid & 63, wave = __builtin_amdgcn_readfirstlane(tid >> 6);
    const float* par = (const float*)(ws + WS_PAR);
    const float* lnstat = (const float*)(ws + WS_LNSTAT); const bf16* wsp = (const bf16*)(ws + WS_WSP);
    bf16* mix = (bf16*)(ws + WS_MIX); float* ssmix = (float*)(ws + WS_SSMIX);
    const int gb = gu >> 3, h = gu & 7, tok0 = gb * 128, fr = lane & 15, fq = lane >> 4;
    LAS unsigned char* VN = lds;
    const int c = tid & 15, r0 = tid >> 4;
    v4u raw[4]; f32x2 stv[4];
    tile_ld(raw, proj, tok0, C_VG + h * 128, tid);
#pragma unroll
    for (int p = 0; p < 4; ++p) stv[p] = *(const f32x2*)(lnstat + 2 * (tok0 + r0 + 32 * p));
    const f32x4 g0 = *(const f32x4*)(par + PAR_GV + h * 128 + 8 * c), g1 = *(const f32x4*)(par + PAR_GV + h * 128 + 8 * c + 4);
    const f32x4 b0 = *(const f32x4*)(par + PAR_BV + h * 128 + 8 * c), b1 = *(const f32x4*)(par + PAR_BV + h * 128 + 8 * c + 4);
    bf16x8 wf[4];
#pragma unroll
    for (int s = 0; s < 4; ++s) wf[s] = *(const bf16x8*)(wsp + ((size_t)(h * 128 + 16 * wave + fr) * 128 + 32 * s + 8 * fq));
    const int tok = tok0 + 16 * wave + fr; const float bsp = par[PAR_BSP + h * 128 + 16 * wave + fr];
    const bf16* urow = proj + (size_t)tok * INW + C_U + h * 128 + 4 * fq; bf16* orow = mix + (size_t)tok * D + 1024 + h * 128 + 4 * fq;
    v2u uw[8];
#pragma unroll
    for (int ct = 0; ct < 8; ++ct) uw[ct] = *(const v2u*)(urow + 16 * ct);
    __syncthreads();
#pragma unroll
    for (int p = 0; p < 4; ++p) {
        const float mu = stv[p][0] * (1.0f / 1024.0f), var = fmaxf(stv[p][1] * (1.0f / 1024.0f) - mu * mu, 0.f), rstd = 1.0f / sqrtf(var + pg8::EPSN);
        float v[8];
        v[0] = bflo(raw[p].x); v[1] = bfhi(raw[p].x); v[2] = bflo(raw[p].y); v[3] = bfhi(raw[p].y); v[4] = bflo(raw[p].z); v[5] = bfhi(raw[p].z); v[6] = bflo(raw[p].w); v[7] = bfhi(raw[p].w);
#pragma unroll
        for (int e = 0; e < 4; ++e) { v[e] = (v[e] - mu) * rstd * g0[e] + b0[e]; v[4 + e] = (v[4 + e] - mu) * rstd * g1[e] + b1[e]; }
        v4u o; o.x = pk2(v[0], v[1]); o.y = pk2(v[2], v[3]); o.z = pk2(v[4], v[5]); o.w = pk2(v[6], v[7]);
        *(LAS v4u*)(VN + (r0 + 32 * p) * V_STRIDE + c * 16) = o;
    }
    __syncthreads();
    f32x4 acc[8];
#pragma unroll
    for (int ct = 0; ct < 8; ++ct) {
        acc[ct] = (f32x4){0.f, 0.f, 0.f, 0.f};
#pragma unroll
        for (int s = 0; s < 4; ++s) {
            const LAS unsigned char* p0 = VN + (32 * s + 8 * fq + (fr >> 2)) * V_STRIDE + (16 * ct + 4 * (fr & 3)) * 2;
            const bf16x8 vf = tr_frag(p0, p0 + 4 * V_STRIDE);
            acc[ct] = __builtin_amdgcn_mfma_f32_16x16x32_bf16(vf, wf[s], acc[ct], 0, 0, 0);
        }
    }
    float ss = 0.f;
#pragma unroll
    for (int ct = 0; ct < 8; ++ct) {
        const float o0 = bflo(uw[ct].x) * (acc[ct][0] + bsp), o1 = bfhi(uw[ct].x) * (acc[ct][1] + bsp), o2 = bflo(uw[ct].y) * (acc[ct][2] + bsp), o3 = bfhi(uw[ct].y) * (acc[ct][3] + bsp);
        ss += (o0 * o0 + o1 * o1) + (o2 * o2 + o3 * o3);
        v2u w; w.x = pk2(o0, o1); w.y = pk2(o2, o3); *(v2u*)(orow + 16 * ct) = w;
    }
    ss += __shfl_xor(ss, 16); ss += __shfl_xor(ss, 32);
    if (fq == 0) unsafeAtomicAdd(ssmix + (size_t)tok * 2 + 1, ss);
}

__device__ __forceinline__ void convert_out_down(const Args& A, LAS unsigned char* lds, int vcu, int G) {
    int tid = threadIdx.x; asm volatile("" : "+v"(tid)); const int lane = tid & 63, wave = __builtin_amdgcn_readfirstlane(tid >> 6);
    unsigned char* ws = A.ws;
    __syncthreads();
    LAS float* scr = (LAS float*)(lds + wave * 16640);
    constexpr int I_OUT0 = (D / 64) * (D / 64), I_DN0 = (FF / 64) * (D / 64);
    for (int it = vcu * NW + wave; it < I_OUT0 + I_DN0; it += G * NW) {
        if (it < I_OUT0) transpose_tile(A.w_out, D, D, (bf16*)(ws + WS_WOUT), A.g_ao, A.g_go, 1024, scr, it, lane);
        else transpose_tile(A.w_down, FF, D, (bf16*)(ws + WS_WDOWN), nullptr, nullptr, 0, scr, it - I_OUT0, lane);
    }
    __syncthreads();
}

template <int HF> __device__ __forceinline__ void ffn_half(const Args& A, LAS unsigned char* lds, int G, int bx, const XcdBarrier& xb) {
    unsigned char* ws = A.ws;
    bf16* HID = (bf16*)(ws + WS_HID);
    {
        pg8::Gemm g{(const bf16*)(ws + WS_XB) + (size_t)HF * TH * D, (const bf16*)(ws + WS_WUP), TH, FF, D, D}; pg8::StaticOrder S; S.init(TH, FF, G, bx, 4);
        pg8::EpiUp E{HID, (const float*)(ws + WS_SS2) + HF * TH};
        pg8::gemm_phase<pg8::EpiUp, pg8::StaticOrder, true, true>(lds, g, S, E);
    }
    xcd_barrier(xb);
    {
        pg8::Gemm g{HID, (const bf16*)(ws + WS_WDOWN), TH, D, FF, FF}; pg8::StaticOrder S; S.init(TH, D, G, bx, 4);
        pg8::EpiDown E{A.out + (size_t)HF * TH * D, (const bf16*)(ws + WS_XB) + (size_t)HF * TH * D};
        pg8::gemm_phase<pg8::EpiDown, pg8::StaticOrder, true, true>(lds, g, S, E);
    }
}

__global__ void __launch_bounds__(NT, 2) fwd_mega(Args A) {
    extern __shared__ __attribute__((aligned(16))) unsigned char lds_raw[];
    LAS unsigned char* lds = (LAS unsigned char*)lds_raw;
    cg::grid_group grid = cg::this_grid();
    const int tid = threadIdx.x, lane = tid & 63, wave = __builtin_amdgcn_readfirstlane(tid >> 6);
    const int G = gridDim.x, bx = blockIdx.x;
    const int vcu = (G % 8 == 0) ? (bx % 8) * (G / 8) + bx / 8 : bx;
    unsigned char* ws = A.ws;
    bf16* WinT = (bf16*)(ws + WS_WIN); bf16* WoutT = (bf16*)(ws + WS_WOUT); bf16* WupT = (bf16*)(ws + WS_WUP); bf16* WdownT = (bf16*)(ws + WS_WDOWN);
    bf16* XB = (bf16*)(ws + WS_XB); bf16* HID = (bf16*)(ws + WS_HID); bf16* MIX = (bf16*)(ws + WS_MIX);
    float* lnstat = (float*)(ws + WS_LNSTAT); float* ss2 = (float*)(ws + WS_SS2); float* r1 = (float*)(ws + WS_R1); float* ssmix = (float*)(ws + WS_SSMIX);
    bf16* PROJ = (bf16*)A.out;
    if (tid < 2) ((LAS unsigned*)(lds + LDS_BARST))[tid] = 0u;
    unsigned* barw = (unsigned*)(ws + WS_BAR);
    if (bx == 0) for (int i = tid; i < XCD_BAR_WORDS; i += NT) barw[i] = 0u;
    grid.sync();
    XcdBarrier xbar; xbar.bar = barw; xbar.x = xb_xcc_id(); xbar.st = (volatile LAS unsigned*)(lds + LDS_BARST);
    if (tid == 0) ((LAS unsigned*)(lds + LDS_BARST))[2] = xb_add(&barw[XB_XCNT(xbar.x)], 1u);

    {
        const int gw = vcu * NW + wave, NGW = G * NW;
        LAS float* scr = (LAS float*)(lds + wave * 16640);
        constexpr int I_IN = (D / 64) * (INW / 64);
        for (int it = gw; it < I_IN; it += NGW) transpose_tile(A.w_in, D, INW, WinT, A.g_mix, A.g_mix, D, scr, it, lane);
        for (int m = gw; m < T; m += NGW) {
            const float* xrow = (m < 8192) ? A.xp + (size_t)m * D : A.xs + (size_t)(m - 8192) * D;
            const f32x4* xr = (const f32x4*)xrow + lane; f32x4 v[8]; float s = 0.f;
#pragma unroll
            for (int j = 0; j < 8; ++j) { v[j] = __builtin_nontemporal_load(xr + 64 * j); s += (v[j][0] * v[j][0] + v[j][1] * v[j][1]) + (v[j][2] * v[j][2] + v[j][3] * v[j][3]); }
            s = wave_sum(s);
            if (lane == 0) r1[m] = 1.0f / sqrtf(s * (1.0f / D) + pg8::EPSN);
            v2u* o8 = (v2u*)(XB + (size_t)m * D) + lane;
#pragma unroll
            for (int j = 0; j < 8; ++j) { v2u w; w.x = pk2(v[j][0], v[j][1]); w.y = pk2(v[j][2], v[j][3]); o8[64 * j] = w; }
        }
        const int gt = vcu * NT + tid, NGT = G * NT;
        for (int i = gt; i < 8 * 128 * 128; i += NGT) ((bf16*)(ws + WS_WSP))[i] = (bf16)f2bf(A.w_sp[i]);
        for (int i = gt; i < 4096 * 16; i += NGT) {
            const int pos = i >> 4, k = i & 15;
            const float inv_freq = __builtin_amdgcn_exp2f(-(float)k * (18.931568569324174f / 16.0f));
            const float ang = (float)pos * inv_freq, rev = ang * 0.15915494309189535f, fr = rev - floorf(rev);
            float* tp = (float*)(ws + WS_TAB) + 2 * (size_t)i; tp[0] = __builtin_amdgcn_cosf(fr); tp[1] = __builtin_amdgcn_sinf(fr);
        }
        for (int i = gt; i < PAR_N; i += NGT) {
            float v = 0.f;
            if (i < PAR_GK) v = A.g_q[i]; else if (i < PAR_SINK) v = A.g_k[i - PAR_GK]; else if (i < PAR_SINK + 8) v = A.sink[i - PAR_SINK];
            else if (i < PAR_GV) v = 0.f; else if (i < PAR_BV) v = A.g_v_ln[i - PAR_GV]; else if (i < PAR_BSP) v = A.b_v_ln[i - PAR_BV]; else v = A.b_sp[i - PAR_BSP];
            ((float*)(ws + WS_PAR))[i] = v;
        }
        for (int i = gt; i < 2 * T; i += NGT) { lnstat[i] = 0.f; ssmix[i] = 0.f; }
        for (int i = gt; i < T; i += NGT) ss2[i] = 0.f;
    }
    xcd_barrier(xbar);
    if (tid == 0) {
        bool ok = (G % 8 == 0);
        for (unsigned j = 0; j < 16; ++j) { const unsigned cj = xb_ld(&barw[XB_XCNT(j)]); ok = ok && ((j < 8) ? (cj == (unsigned)(G / 8)) : (cj == 0u)); }
        LAS unsigned* st = (LAS unsigned*)(lds + LDS_BARST); st[3] = ok ? (st[2] * 8u + xbar.x) : (unsigned)bx;
    }
    __syncthreads();
    const int cid = __builtin_amdgcn_readfirstlane((int)((LAS unsigned*)(lds + LDS_BARST))[3]);
    const int vcu2 = (G % 8 == 0) ? (cid % 8) * (G / 8) + cid / 8 : cid;
    {
        pg8::Gemm g{XB, WinT, T, INW, D, D}; pg8::StaticOrder S; S.init(T, INW, G, cid, 4);
        pg8::EpiProj E{PROJ, r1, lnstat, (const float*)(ws + WS_PAR) + PAR_GQ, (const float*)(ws + WS_PAR) + PAR_GK, (const float*)(ws + WS_TAB), (LAS float*)(lds + 131072)};
        pg8::gemm_phase<pg8::EpiProj, pg8::StaticOrder, true, true>(lds, g, S, E);
        constexpr int NU = (T / 256) * (INW / 256);
        const int rem = NU % G, NH = (rem == 0) ? G : G - rem, hi = (rem == 0) ? cid : cid - rem;
        if (hi >= 0) {
            constexpr int I_UP = (D / 64) * (FF / 64);
            LAS float* scr = (LAS float*)(lds + wave * 16640);
            for (int it = hi * NW + wave; it < I_UP; it += NH * NW) transpose_tile(A.w_up, D, FF, WupT, A.g_ffn, A.g_ffn, D, scr, it, lane);
        }
    }
    xcd_barrier(xbar);
    if (!(vcu2 & 1)) convert_out_down(A, lds, vcu2, G);
#pragma unroll 1
    for (int u = vcu2; u < 1536; u += G) {
        if (u < 512) attn_unit(PROJ, ws, lds, u);
        else gmlp_unit(PROJ, ws, lds, u - 512);
    }
    if (vcu2 & 1) convert_out_down(A, lds, vcu2, G);
    xcd_barrier(xbar);
    {
        pg8::Gemm g{MIX, WoutT, T, D, D, D}; pg8::StaticOrder S; S.init(T, D, G, cid, 4);
        LAS pg8::f32x2* sct = (LAS pg8::f32x2*)(lds + 131072);
        for (int e = tid; e < 7 * 256; e += NT) {
            pg8::Unit u; if (!S.next(e >> 8, u)) break;
            const pg8::f32x2 p = *(const pg8::f32x2*)(ssmix + (size_t)(u.pm * 256 + (e & 255)) * 2);
            const float va = p[0] * (1.0f / 1024.0f) + pg8::EPSN, vg = p[1] * (1.0f / 1024.0f) + pg8::EPSN;
            pg8::f32x2 o; o[1] = __builtin_amdgcn_rsqf(vg); o[0] = __builtin_amdgcn_rsqf(va) * __builtin_amdgcn_sqrtf(vg); sct[e] = o;
        }
        __syncthreads();
        pg8::EpiOut E{XB, ss2, sct};
        pg8::gemm_phase<pg8::EpiOut, pg8::StaticOrder, true, true>(lds, g, S, E);
    }
    xcd_barrier(xbar);
    ffn_half<0>(A, lds, G, cid, xbar);
    xcd_barrier(xbar);
    ffn_half<1>(A, lds, G, cid, xbar);
}

extern "C" void kernel_launch(void* const* d_in, const int* in_sizes, int n_in, void* d_out, int out_size, void* d_ws, size_t ws_size, hipStream_t stream) {
    static int grid = 0;
    if (grid == 0) {
        if (n_in != 17 || out_size != T * D || ws_size < WS_END) { fprintf(stderr, "kernel_launch: unexpected sizes n_in %d out %d ws %zu (need %zu)\n", n_in, out_size, ws_size, (size_t)WS_END); }
        int dev = 0, cus = 0, per_cu = 0;
        (void)hipGetDevice(&dev); (void)hipDeviceGetAttribute(&cus, hipDeviceAttributeMultiprocessorCount, dev);
        if (hipFuncSetAttribute((const void*)fwd_mega, hipFuncAttributeMaxDynamicSharedMemorySize, LDS_BYTES) != hipSuccess) fprintf(stderr, "kernel_launch: hipFuncSetAttribute failed\n");
        if (hipOccupancyMaxActiveBlocksPerMultiprocessor(&per_cu, (const void*)fwd_mega, NT, LDS_BYTES) != hipSuccess || per_cu < 1) { fprintf(stderr, "kernel_launch: occupancy query gave %d\n", per_cu); per_cu = 1; }
        (void)hipGetLastError();
        if (cus <= 0) cus = 256;
        grid = cus * per_cu;
        fprintf(stderr, "kernel_launch: grid %d (cus %d per_cu %d) ws %zu\n", grid, cus, per_cu, ws_size);
    }
    Args a{};
    a.xp = (const float*)d_in[0]; a.xs = (const float*)d_in[1]; a.g_mix = (const float*)d_in[2]; a.w_in = (const float*)d_in[3]; a.g_q = (const float*)d_in[4]; a.g_k = (const float*)d_in[5];
    a.sink = (const float*)d_in[6]; a.g_v_ln = (const float*)d_in[7]; a.b_v_ln = (const float*)d_in[8]; a.w_sp = (const float*)d_in[9]; a.b_sp = (const float*)d_in[10];
    a.g_ao = (const float*)d_in[11]; a.g_go = (const float*)d_in[12]; a.w_out = (const float*)d_in[13]; a.g_ffn = (const float*)d_in[14]; a.w_up = (const float*)d_in[15]; a.w_down = (const float*)d_in[16];
    a.out = (float*)d_out; a.ws = (unsigned char*)d_ws;
    void* args[] = {&a};
    hipError_t e = hipLaunchCooperativeKernel((const void*)fwd_mega, dim3(grid), dim3(NT), args, LDS_BYTES, stream);
    if (e != hipSuccess) fprintf(stderr, "kernel_launch: cooperative launch failed: %s (grid %d)\n", hipGetErrorString(e), grid);
}
```

```cpp
#include <hip/hip_runtime.h>
#include <hip/hip_cooperative_groups.h>
#include <cstdio>
#include <cstdint>
namespace cg = cooperative_groups;
namespace pg8 {
#define PG8_LAS __attribute__((address_space(3)))
typedef unsigned short bf16_t;
typedef short bf16x8 __attribute__((ext_vector_type(8)));
typedef float f32x4 __attribute__((ext_vector_type(4)));
typedef unsigned u32x4 __attribute__((ext_vector_type(4)));
constexpr int BM = 256, BK = 64, HALF = 128, HTB = HALF * BK * 2  , STAGE_BYTES = 8 * HTB, NXCD = 8, WGM = 8;

__host__ __device__ __forceinline__ int lds_byte(int r, int c) { const int st = (r >> 4) * 2 + (c >> 5), rr = r & 15, cc = c & 31, ob = rr * 64 + cc * 2; return st * 1024 + (ob ^ (((ob >> 9) & 1) << 5)); }
__host__ __device__ __forceinline__ void stage_rc(int b, int& R, int& C) { const int st = b / 1024, sb = b % 1024, swz = sb ^ (((sb >> 9) & 1) << 5); R = (st >> 1) * 16 + swz / 64; C = (st & 1) * 32 + (swz % 64) / 2; }
__host__ __device__ __forceinline__ int perm32(int rho) { const int n = rho >> 4, i = rho & 15; return 8 * (i >> 2) + 4 * n + (i & 3); }

struct Unit { int pm, pn, kh, slot; };
struct Gemm { const bf16_t* A; const bf16_t* Bt; int M, N, K, ld; };

struct StaticOrder {
    int nM, nN, nwg, G, c, wgm;
    __host__ __device__ void init(int M, int N, int G_, int c_, int wgm_ = WGM) { nM = M / BM; nN = N / BM; nwg = nM * nN; G = G_; c = c_; wgm = wgm_; }
    __host__ __device__ bool next(int i, Unit& u) const {
        const long L = (long)i * G + c; if (L >= nwg) return false;
        int wgid = (int)L; { const int q = nwg / NXCD, r = nwg % NXCD, xcd = wgid % NXCD, off = wgid / NXCD; wgid = (xcd < r ? xcd * (q + 1) : r * (q + 1) + (xcd - r) * q) + off; }
        const int nig = wgm * nN, gid = wgid / nig, fm = gid * wgm, gsz = (nM - fm) < wgm ? (nM - fm) : wgm;
        u.pm = fm + ((wgid % nig) % gsz); u.pn = (wgid % nig) / gsz; u.kh = 0; u.slot = i; return true;
    }
    __device__ __forceinline__ void a_ready(const Unit&) const {}
    __device__ __forceinline__ void done(const Unit&) const {}
};
__device__ __forceinline__ unsigned cvt_pk_bf16(float lo, float hi) { unsigned r; asm volatile("v_cvt_pk_bf16_f32 %0, %1, %2" : "=v"(r) : "v"(lo), "v"(hi)); return r; }
struct SplitOrder : StaticOrder {
    __host__ __device__ bool next(int i, Unit& u) const { if (!StaticOrder::next(i >> 1, u)) return false; u.kh = i & 1; u.slot = i >> 1; return true; }
};
typedef float f32x2 __attribute__((ext_vector_type(2)));
typedef unsigned u32x2 __attribute__((ext_vector_type(2)));
__device__ __forceinline__ float gelu_tanh(float x) {
    const float t = x * x * 0.044715f + 1.0f;
    const float e = __builtin_amdgcn_exp2f(x * t * (-2.0f * 0.7978845608028654f * 1.4426950408889634f));
    return x * __builtin_amdgcn_rcpf(1.0f + e);
}
constexpr int PROJ_LD = 3584, DM = 2048, DFF = 8192;
constexpr float EPSN = 1e-6f;

struct EpiProj {
    static constexpr bool PERM = true, AFTER_DRAIN = false, MID = false, MIDLOOP = false;
    bf16_t* O; const float* r1; float* lnstat; const float* gq; const float* gk; const float* tab; PG8_LAS float* xch;
    __device__ __forceinline__ void operator()(const f32x4 (&acc)[2][2][4][2], const Unit& u, int wr, int wc, int fr, int fq) const {
        const int row0 = u.pm * BM + wr * 64 + fr, col0 = u.pn * BM + wc * 32 + 8 * fq;
        if (u.pn <= 4) {
            float rsv[2][4];
#pragma unroll
            for (int ai = 0; ai < 2; ++ai)
#pragma unroll
                for (int m = 0; m < 4; ++m) {
                    const float rs = r1[row0 + ai * HALF + m * 16]; rsv[ai][m] = rs;
#pragma unroll
                    for (int bj = 0; bj < 2; ++bj) {
                        const f32x4 v0 = acc[ai][bj][m][0] * rs, v1 = acc[ai][bj][m][1] * rs;
                        float s = (v0[0] * v0[0] + v0[1] * v0[1]) + (v0[2] * v0[2] + v0[3] * v0[3]) + (v1[0] * v1[0] + v1[1] * v1[1]) + (v1[2] * v1[2] + v1[3] * v1[3]);
                        s += __shfl_xor(s, 16); s += __shfl_xor(s, 32);
                        if (fq == 0) xch[((((wr * 4 + wc) * 2 + ai) * 4 + m) * 2 + bj) * 16 + fr] = s;
                    }
                }
            asm volatile("s_waitcnt lgkmcnt(0)" ::: "memory"); __builtin_amdgcn_s_barrier(); asm volatile("" ::: "memory");
            const bool isq = u.pn < 4; const float* gp = (isq ? gq : gk) + wc * 32 + 8 * fq;
            const f32x4 g0 = *(const f32x4*)gp, g1 = *(const f32x4*)(gp + 4);
            const float osc = isq ? 0.08838834764831845f * 1.4426950408889634f : 1.0f;
#pragma unroll
            for (int ai = 0; ai < 2; ++ai)
#pragma unroll
                for (int m = 0; m < 4; ++m) {
                    const int row = row0 + ai * HALF + m * 16; const float rs = rsv[ai][m];
                    bf16_t* rowp = O + (size_t)row * PROJ_LD + col0;
                    f32x4 c0 = {0.f, 0.f, 0.f, 0.f}, c1 = c0, c2 = c0, c3 = c0;
                    if (wc == 0) { const int pos = (row < 8192) ? (row & 4095) : (row & 2047); const f32x4* tp = (const f32x4*)(tab + ((size_t)pos * 16 + 8 * (fq & 1)) * 2); c0 = tp[0]; c1 = tp[1]; c2 = tp[2]; c3 = tp[3]; }
#pragma unroll
                    for (int bj = 0; bj < 2; ++bj) {
                        float tot = 0.f;
#pragma unroll
                        for (int w = 0; w < 4; ++w) tot += xch[((((wr * 4 + w) * 2 + ai) * 4 + m) * 2 + bj) * 16 + fr];
                        const float sc = rs * __builtin_amdgcn_rsqf(tot * (1.0f / 128.0f) + EPSN);
                        f32x4 v0 = acc[ai][bj][m][0] * sc * g0, v1 = acc[ai][bj][m][1] * sc * g1;
                        if (wc == 0) {
                            f32x4 p0, p1;
#pragma unroll
                            for (int j = 0; j < 4; ++j) { p0[j] = __shfl_xor(v0[j], 32); p1[j] = __shfl_xor(v1[j], 32); }
                            const float sg = (fq < 2) ? -1.0f : 1.0f;
                            v0[0] = v0[0] * c0[0] + sg * p0[0] * c0[1]; v0[1] = v0[1] * c0[2] + sg * p0[1] * c0[3]; v0[2] = v0[2] * c1[0] + sg * p0[2] * c1[1]; v0[3] = v0[3] * c1[2] + sg * p0[3] * c1[3];
                            v1[0] = v1[0] * c2[0] + sg * p1[0] * c2[1]; v1[1] = v1[1] * c2[2] + sg * p1[1] * c2[3]; v1[2] = v1[2] * c3[0] + sg * p1[2] * c3[1]; v1[3] = v1[3] * c3[2] + sg * p1[3] * c3[3];
                        }
                        v0 *= osc; v1 *= osc;
                        u32x4 w; w.x = cvt_pk_bf16(v0[0], v0[1]); w.y = cvt_pk_bf16(v0[2], v0[3]); w.z = cvt_pk_bf16(v1[0], v1[1]); w.w = cvt_pk_bf16(v1[2], v1[3]);
                        __builtin_nontemporal_store(w, (u32x4*)(rowp + bj * HALF));
                    }
                }
            return;
        }
        const bool act = u.pn >= 6, st = u.pn >= 10;
#pragma unroll
        for (int ai = 0; ai < 2; ++ai)
#pragma unroll
            for (int m = 0; m < 4; ++m) {
                const int row = row0 + ai * HALF + m * 16; const float rs = r1[row];
                bf16_t* rowp = O + (size_t)row * PROJ_LD + col0; float s1 = 0.f, s2 = 0.f;
#pragma unroll
                for (int bj = 0; bj < 2; ++bj) {
                    f32x4 v0 = acc[ai][bj][m][0] * rs, v1 = acc[ai][bj][m][1] * rs;
                    if (act) {
#pragma unroll
                        for (int j = 0; j < 4; ++j) { v0[j] = gelu_tanh(v0[j]); v1[j] = gelu_tanh(v1[j]); }
                    }
                    if (st) {
#pragma unroll
                        for (int j = 0; j < 4; ++j) { s1 += v0[j] + v1[j]; s2 += v0[j] * v0[j] + v1[j] * v1[j]; }
                    }
                    u32x4 w; w.x = cvt_pk_bf16(v0[0], v0[1]); w.y = cvt_pk_bf16(v0[2], v0[3]); w.z = cvt_pk_bf16(v1[0], v1[1]); w.w = cvt_pk_bf16(v1[2], v1[3]);
                    __builtin_nontemporal_store(w, (u32x4*)(rowp + bj * HALF));
                }
                if (st && lnstat) {
                    s1 += __shfl_xor(s1, 16); s1 += __shfl_xor(s1, 32); s2 += __shfl_xor(s2, 16); s2 += __shfl_xor(s2, 32);
                    if (fq == 0) { unsafeAtomicAdd(lnstat + 2 * row, s1); unsafeAtomicAdd(lnstat + 2 * row + 1, s2); }
                }
            }
    }
};
struct EpiOut {
    static constexpr bool PERM = false, AFTER_DRAIN = false, MID = false, MIDLOOP = true;
    bf16_t* x1b; float* ss2; const PG8_LAS f32x2* sct;
    __device__ __forceinline__ void midloop(f32x4 (&acc)[2][2][4][2], const Unit& u, int wr, int fr) const {
        const PG8_LAS f32x2* p = sct + u.slot * 256 + wr * 64 + fr;
#pragma unroll
        for (int ai = 0; ai < 2; ++ai)
#pragma unroll
            for (int m = 0; m < 4; ++m) {
                const float ratio = p[ai * HALF + m * 16][0];
#pragma unroll
                for (int bj = 0; bj < 2; ++bj)
#pragma unroll
                    for (int n = 0; n < 2; ++n) acc[ai][bj][m][n] *= ratio;
            }
    }
    __device__ __forceinline__ void operator()(const f32x4 (&acc)[2][2][4][2], const Unit& u, int wr, int wc, int fr, int fq) const {
        const int row0 = u.pm * BM + wr * 64 + fr, col0 = u.pn * BM + wc * 32 + 4 * fq;
        const PG8_LAS f32x2* p = sct + u.slot * 256 + wr * 64 + fr;
#pragma unroll
        for (int ai = 0; ai < 2; ++ai)
#pragma unroll
            for (int m = 0; m < 4; ++m) {
                const int row = row0 + ai * HALF + m * 16; const float rg = p[ai * HALF + m * 16][1];
                bf16_t* brow = x1b + (size_t)row * DM + col0; float sq = 0.f;
#pragma unroll
                for (int bj = 0; bj < 2; ++bj)
#pragma unroll
                    for (int n = 0; n < 2; ++n) {
                        const u32x2 xw = *(const u32x2*)(brow + bj * HALF + n * 16);
                        f32x4 v = acc[ai][bj][m][n] * rg;
                        v[0] += __builtin_bit_cast(float, xw.x << 16); v[1] += __builtin_bit_cast(float, xw.x & 0xffff0000u); v[2] += __builtin_bit_cast(float, xw.y << 16); v[3] += __builtin_bit_cast(float, xw.y & 0xffff0000u);
                        u32x2 w; w.x = cvt_pk_bf16(v[0], v[1]); w.y = cvt_pk_bf16(v[2], v[3]); *(u32x2*)(brow + bj * HALF + n * 16) = w;
                        sq += (v[0] * v[0] + v[1] * v[1]) + (v[2] * v[2] + v[3] * v[3]);
                    }
                sq += __shfl_xor(sq, 16); sq += __shfl_xor(sq, 32);
                if (fq == 0) unsafeAtomicAdd(ss2 + row, sq);
            }
    }
};
struct EpiUp {
    static constexpr bool PERM = true, AFTER_DRAIN = false, MID = false, MIDLOOP = false;
    bf16_t* H; const float* ss2;
    __device__ __forceinline__ void operator()(const f32x4 (&acc)[2][2][4][2], const Unit& u, int wr, int wc, int fr, int fq) const {
        const int row0 = u.pm * BM + wr * 64 + fr, col0 = u.pn * BM + wc * 32 + 8 * fq;
#pragma unroll
        for (int ai = 0; ai < 2; ++ai)
#pragma unroll
            for (int m = 0; m < 4; ++m) {
                const int row = row0 + ai * HALF + m * 16; const float rs = 1.0f / sqrtf(ss2[row] * (1.0f / 2048.0f) + EPSN);
                bf16_t* rowp = H + (size_t)row * DFF + col0;
#pragma unroll
                for (int bj = 0; bj < 2; ++bj) {
                    f32x4 v0 = acc[ai][bj][m][0] * rs, v1 = acc[ai][bj][m][1] * rs;
#pragma unroll
                    for (int j = 0; j < 4; ++j) { v0[j] = fmaxf(v0[j], 0.f); v0[j] *= v0[j]; v1[j] = fmaxf(v1[j], 0.f); v1[j] *= v1[j]; }
                    u32x4 w; w.x = cvt_pk_bf16(v0[0], v0[1]); w.y = cvt_pk_bf16(v0[2], v0[3]); w.z = cvt_pk_bf16(v1[0], v1[1]); w.w = cvt_pk_bf16(v1[2], v1[3]);
                    *(u32x4*)(rowp + bj * HALF) = w;
                }
            }
    }
};
struct EpiDown {
    static constexpr bool PERM = false, AFTER_DRAIN = false, MID = false, MIDLOOP = false;
    float* out; const bf16_t* x1b;
    __device__ __forceinline__ void operator()(const f32x4 (&acc)[2][2][4][2], const Unit& u, int wr, int wc, int fr, int fq) const {
        const int row0 = u.pm * BM + wr * 64 + fr, col0 = u.pn * BM + wc * 32 + 4 * fq;
#pragma unroll
        for (int ai = 0; ai < 2; ++ai)
#pragma unroll
            for (int m = 0; m < 4; ++m) {
                const size_t off = (size_t)(row0 + ai * HALF + m * 16) * DM + col0;
#pragma unroll
                for (int bj = 0; bj < 2; ++bj)
#pragma unroll
                    for (int n = 0; n < 2; ++n) { const u32x2 xw = *(const u32x2*)(x1b + off + bj * HALF + n * 16); f32x4 v = acc[ai][bj][m][n];
                        v[0] += __builtin_bit_cast(float, xw.x << 16); v[1] += __builtin_bit_cast(float, xw.x & 0xffff0000u); v[2] += __builtin_bit_cast(float, xw.y << 16); v[3] += __builtin_bit_cast(float, xw.y & 0xffff0000u);
                        __builtin_nontemporal_store(v, (f32x4*)(out + off + bj * HALF + n * 16)); }
            }
    }
};

template <class Epi, class Sched, bool ALIGN_EPI = false, bool SP2 = false>
__device__ __forceinline__ void gemm_phase(PG8_LAS unsigned char* lds, const Gemm g, const Sched& S, const Epi& E) {
    int tid_ = threadIdx.x; asm volatile("" : "+v"(tid_));
    const int tid = tid_, wid = __builtin_amdgcn_readfirstlane(tid >> 6), lane = tid & 63, wr = wid >> 2, wc = wid & 3, fr = lane & 15, fq = lane >> 4;
    const int K = g.K, nt = K / BK, LD = g.ld;
    unsigned voffA[2], voffB[2];
#pragma unroll
    for (int i = 0; i < 2; ++i) { int R, C; stage_rc(tid * 16 + i * 8192, R, C); const int Rb = Epi::PERM ? ((R & ~31) + perm32(R & 31)) : R;
        voffA[i] = (unsigned)(R * LD + C) * 2u; voffB[i] = (unsigned)(Rb * LD + C) * 2u; }
    const size_t kstep = (size_t)(BK * 2);
    const size_t hstep = (size_t)HALF * LD * 2;
    const size_t tstep = 2 * hstep;
    const unsigned ldsw = (unsigned)wid * 1024u;
    const int aoff = lds_byte(wr * 64 + fr, fq * 8), boff = lds_byte(wc * 32 + fr, fq * 8);
#define PG8_SA(b, h) (((b) * 2 + (h)) * HTB)
#define PG8_SB(b, h) ((4 + (b) * 2 + (h)) * HTB)
#define PG8_STAGE(bufoff, gbase, voff) do { _Pragma("unroll") for (int _i = 0; _i < 2; ++_i) \
        __builtin_amdgcn_global_load_lds((const unsigned*)((const char*)(gbase) + (voff)[_i]), (PG8_LAS unsigned*)(lds + (bufoff) + ldsw + _i * 8192), 16, 0, 0); } while (0)
#define PG8_LDA(dst, b, h) do { _Pragma("unroll") for (int m = 0; m < 4; ++m) _Pragma("unroll") for (int k = 0; k < 2; ++k) dst[m][k] = *(const PG8_LAS bf16x8*)(lds + PG8_SA(b, h) + aoff + m * 2048 + k * 1024); } while (0)
#define PG8_LDB(dst, b, h) do { _Pragma("unroll") for (int n = 0; n < 2; ++n) _Pragma("unroll") for (int k = 0; k < 2; ++k) dst[n][k] = *(const PG8_LAS bf16x8*)(lds + PG8_SB(b, h) + boff + n * 2048 + k * 1024); } while (0)
#define PG8_MMA(ai, bj, At, Bt) do { __builtin_amdgcn_s_setprio(1); _Pragma("unroll") for (int m = 0; m < 4; ++m) _Pragma("unroll") for (int n = 0; n < 2; ++n) _Pragma("unroll") for (int k = 0; k < 2; ++k) \
        acc[ai][bj][m][n] = __builtin_amdgcn_mfma_f32_16x16x32_bf16(Bt[n][k], At[m][k], acc[ai][bj][m][n], 0, 0, 0); __builtin_amdgcn_s_setprio(0); } while (0)
#define PG8_WAIT_V(n) asm volatile("s_waitcnt vmcnt(" #n ")" ::: "memory")
#define PG8_WAIT_L(n) asm volatile("s_waitcnt lgkmcnt(" #n ")" ::: "memory")
#define PG8_BAR __builtin_amdgcn_s_barrier()
#define PG8_SCHED __builtin_amdgcn_sched_barrier(0)
    Unit cur, nxt; int ui = 0;
    if (!S.next(0, cur)) return;
    f32x4 acc[2][2][4][2];
#pragma unroll
    for (int a = 0; a < 2; ++a)
#pragma unroll
        for (int b = 0; b < 2; ++b)
#pragma unroll
            for (int m = 0; m < 4; ++m)
#pragma unroll
                for (int n = 0; n < 2; ++n) acc[a][b][m][n] = (f32x4){0.f, 0.f, 0.f, 0.f};
    bf16x8 At[4][2], B0[2][2], B1[2][2];
    const size_t khstep = (size_t)K * 2;
    const char* cA = (const char*)g.A + (size_t)cur.pm * tstep + cur.kh * khstep; const char* cB = (const char*)g.Bt + (size_t)cur.pn * tstep + cur.kh * khstep;
    S.a_ready(cur);
    if constexpr (SP2) {
        PG8_STAGE(PG8_SB(0, 0), cB, voffB); PG8_STAGE(PG8_SB(0, 1), cB + hstep, voffB); PG8_STAGE(PG8_SA(0, 0), cA, voffA); PG8_STAGE(PG8_SA(0, 1), cA + hstep, voffA);
        if (wr == 1) PG8_BAR;
        PG8_WAIT_V(2); PG8_BAR;
        PG8_STAGE(PG8_SB(1, 0), cB + kstep, voffB); PG8_STAGE(PG8_SA(1, 0), cA + kstep, voffA); PG8_STAGE(PG8_SB(1, 1), cB + hstep + kstep, voffB);
        PG8_WAIT_V(6); PG8_BAR;
    } else {
        PG8_STAGE(PG8_SB(0, 0), cB, voffB); PG8_STAGE(PG8_SA(0, 0), cA, voffA); PG8_STAGE(PG8_SB(0, 1), cB + hstep, voffB); PG8_STAGE(PG8_SA(0, 1), cA + hstep, voffA);
        if (wr == 1) PG8_BAR;
        PG8_WAIT_V(4); PG8_BAR;
        PG8_STAGE(PG8_SB(1, 0), cB + kstep, voffB); PG8_STAGE(PG8_SA(1, 0), cA + kstep, voffA); PG8_STAGE(PG8_SB(1, 1), cB + hstep + kstep, voffB);
        PG8_WAIT_V(6); PG8_BAR;
    }
    for (;;) {
        const bool has_next = S.next(ui + 1, nxt);
        const char* nA = has_next ? (const char*)g.A + (size_t)nxt.pm * tstep + nxt.kh * khstep : cA; const char* nB = has_next ? (const char*)g.Bt + (size_t)nxt.pn * tstep + nxt.kh * khstep : cB;
        for (int t = 0; t < nt; t += 2) {
            const bool last = (t == nt - 2);
            const char* a1 = cA + (size_t)(t + 1) * kstep;
            const char* a2 = last ? nA : cA + (size_t)(t + 2) * kstep; const char* b2 = last ? nB : cB + (size_t)(t + 2) * kstep;
            const char* a3 = a2 + kstep; const char* b3 = b2 + kstep;
            if (last && has_next) S.a_ready(nxt);
            if constexpr (Epi::MIDLOOP) { if (t == (nt >> 1)) E.midloop(acc, cur, wr, fr); }
            if constexpr (SP2) {
            PG8_LDB(B0, 0, 0); PG8_LDB(B1, 0, 1); PG8_SCHED; PG8_LDA(At, 0, 0); PG8_STAGE(PG8_SA(1, 1), a1 + hstep, voffA);
            PG8_WAIT_V(8); PG8_WAIT_L(0); PG8_BAR; PG8_MMA(0, 0, At, B0); PG8_MMA(0, 1, At, B1); PG8_BAR; PG8_SCHED;
            PG8_LDA(At, 0, 1); PG8_STAGE(PG8_SB(0, 0), b2, voffB); PG8_STAGE(PG8_SB(0, 1), b2 + hstep, voffB); PG8_STAGE(PG8_SA(0, 0), a2, voffA);
            PG8_WAIT_V(8); PG8_WAIT_L(0); PG8_BAR; PG8_MMA(1, 0, At, B0); PG8_MMA(1, 1, At, B1); PG8_BAR; PG8_SCHED;
            PG8_LDB(B0, 1, 0); PG8_LDB(B1, 1, 1); PG8_SCHED; PG8_LDA(At, 1, 0); PG8_STAGE(PG8_SA(0, 1), a2 + hstep, voffA);
            PG8_WAIT_V(8); PG8_WAIT_L(0); PG8_BAR; PG8_MMA(0, 0, At, B0); PG8_MMA(0, 1, At, B1); PG8_BAR; PG8_SCHED;
            PG8_LDA(At, 1, 1); PG8_STAGE(PG8_SB(1, 0), b3, voffB); PG8_STAGE(PG8_SB(1, 1), b3 + hstep, voffB); PG8_STAGE(PG8_SA(1, 0), a3, voffA);
            PG8_WAIT_V(8); PG8_WAIT_L(0); PG8_BAR; PG8_MMA(1, 0, At, B0); PG8_MMA(1, 1, At, B1); PG8_BAR; PG8_SCHED;
            } else {
            PG8_LDB(B0, 0, 0); PG8_SCHED; PG8_LDA(At, 0, 0); PG8_STAGE(PG8_SA(1, 1), a1 + hstep, voffA);
            PG8_WAIT_L(8); PG8_BAR; PG8_WAIT_L(0); PG8_MMA(0, 0, At, B0); PG8_BAR; PG8_SCHED;
            PG8_LDB(B1, 0, 1); PG8_STAGE(PG8_SB(0, 0), b2, voffB);
            PG8_BAR; PG8_WAIT_L(0); PG8_MMA(0, 1, At, B1); PG8_BAR;
            PG8_LDA(At, 0, 1); PG8_STAGE(PG8_SA(0, 0), a2, voffA);
            PG8_BAR; PG8_WAIT_L(0); PG8_MMA(1, 0, At, B0); PG8_BAR; PG8_SCHED;
            PG8_STAGE(PG8_SB(0, 1), b2 + hstep, voffB);
            PG8_WAIT_V(6); PG8_BAR; PG8_MMA(1, 1, At, B1); PG8_BAR;
            PG8_LDB(B0, 1, 0); PG8_SCHED; PG8_LDA(At, 1, 0); PG8_STAGE(PG8_SA(0, 1), a2 + hstep, voffA);
            PG8_WAIT_L(8); PG8_BAR; PG8_WAIT_L(0); PG8_MMA(0, 0, At, B0); PG8_BAR; PG8_SCHED;
            PG8_LDB(B1, 1, 1); PG8_STAGE(PG8_SB(1, 0), b3, voffB);
            PG8_BAR; PG8_WAIT_L(0); PG8_MMA(0, 1, At, B1); PG8_BAR;
            PG8_LDA(At, 1, 1); PG8_STAGE(PG8_SA(1, 0), a3, voffA);
            PG8_BAR; PG8_WAIT_L(0); PG8_MMA(1, 0, At, B0); PG8_BAR; PG8_SCHED;
            PG8_STAGE(PG8_SB(1, 1), b3 + hstep, voffB);
            PG8_WAIT_V(6); PG8_BAR; PG8_MMA(1, 1, At, B1); PG8_BAR;
            }
        }
        if constexpr (ALIGN_EPI) { if (wr == 0) PG8_BAR; }
        bool keep = false;
        if constexpr (Epi::MID) { if (cur.kh == 0) { E.mid(acc, cur, wr, wc, fr, fq); keep = true; } else E(acc, cur, wr, wc, fr, fq); }
        else if constexpr (!Epi::AFTER_DRAIN) { E(acc, cur, wr, wc, fr, fq); S.done(cur); }
        if (!has_next) break;
        if (!keep) {
#pragma unroll
        for (int a = 0; a < 2; ++a)
#pragma unroll
            for (int b = 0; b < 2; ++b)
#pragma unroll
                for (int m = 0; m < 4; ++m)
#pragma unroll
                    for (int n = 0; n < 2; ++n) acc[a][b][m][n] = (f32x4){0.f, 0.f, 0.f, 0.f};
        }
        cur = nxt; cA = nA; cB = nB; ++ui;
        if constexpr (ALIGN_EPI) { if (wr == 1) PG8_BAR; }
    }
    PG8_WAIT_V(0);
    if constexpr (!ALIGN_EPI) { if (wr == 0) PG8_BAR; }
    PG8_BAR;
    if constexpr (Epi::AFTER_DRAIN) { E.fused(acc, cur, wr, wc, fr, fq, lds, wid, lane); S.done(cur); }
#undef PG8_SA
#undef PG8_SB
#undef PG8_STAGE
#undef PG8_LDA
#undef PG8_LDB
#undef PG8_MMA
#undef PG8_WAIT_V
#undef PG8_WAIT_L
#undef PG8_BAR
#undef PG8_SCHED
}
}

#define LAS __attribute__((address_space(3)))
typedef unsigned short bf16;
typedef float f32x4 __attribute__((ext_vector_type(4)));
typedef short bf16x8 __attribute__((ext_vector_type(8)));
typedef short s16x4 __attribute__((ext_vector_type(4)));
typedef unsigned v4u __attribute__((ext_vector_type(4)));
typedef unsigned v2u __attribute__((ext_vector_type(2)));
typedef float f32x2 __attribute__((ext_vector_type(2)));
constexpr int NW = 8, NT = 512;
constexpr int T = 16384, D = 2048, INW = 3584, FF = 8192, TH = 8192;
constexpr int LDS_BYTES = 147456, LDS_BARST = LDS_BYTES - 64;
constexpr size_t MiB = 1u << 20;
constexpr size_t WS_BAR = 2 * MiB + 65536  , WS_PAR = 2 * MiB, WS_LNSTAT = 0, WS_SS2 = 131072, WS_R1 = 196608, WS_SSMIX = 262144, WS_TAB = 1310720, WS_WSP = 1835008;
constexpr size_t WS_WIN = 3 * MiB, WS_WOUT = 17 * MiB, WS_WUP = 25 * MiB, WS_WDOWN = 57 * MiB, WS_XB = 89 * MiB, WS_HID = 153 * MiB, WS_MIX = 153 * MiB, WS_END = 281 * MiB;
constexpr int PAR_GQ = 0, PAR_GK = 128, PAR_SINK = 256, PAR_GV = 512, PAR_BV = 1536, PAR_BSP = 2560, PAR_N = 3584;
constexpr int C_Q = 0, C_K = 1024, C_V = 1280, C_U = 1536, C_VG = 2560;
constexpr int QK_STRIDE = 272, V_STRIDE = 288;
constexpr int LQ = 0, LK = 2 * 128 * QK_STRIDE, LV = LK + 128 * QK_STRIDE;
static_assert(LV + 128 * V_STRIDE <= LDS_BYTES, "attention LDS");
constexpr float LOG2E = 1.4426950408889634f;

__device__ __forceinline__ unsigned f2bf(float f) { unsigned u = __builtin_bit_cast(unsigned, f); return (u + 0x7fffu + ((u >> 16) & 1u)) >> 16; }
__device__ __forceinline__ unsigned pk2(float lo, float hi) { return pg8::cvt_pk_bf16(lo, hi); }
__device__ __forceinline__ float bflo(unsigned w) { return __builtin_bit_cast(float, w << 16); }
__device__ __forceinline__ float bfhi(unsigned w) { return __builtin_bit_cast(float, w & 0xffff0000u); }
__device__ __forceinline__ float wave_sum(float v) {
#pragma unroll
    for (int o = 1; o < 64; o <<= 1) v += __shfl_xor(v, o);
    return v;
}
#define LDS_WAIT() asm volatile("s_waitcnt lgkmcnt(0)" ::: "memory")

#define RLX_AGENT __ATOMIC_RELAXED, __HIP_MEMORY_SCOPE_AGENT
#define XB_TMO      128
#define XB_XCNT(j)  (256  + 64 * (j))
#define XB_XSUB(j)  (1280 + 64 * (j))
#define XB_XGEN(j)  (2304 + 64 * (j))
#define XB_TOP      3328
#define XB_TOPGEN   3392
#define XCD_BAR_WORDS 3456
#define XB_SPIN_CAP (1u << 18)

__device__ __forceinline__ unsigned xb_ld(unsigned* p)              { return __hip_atomic_load(p, __ATOMIC_RELAXED, __HIP_MEMORY_SCOPE_AGENT); }
__device__ __forceinline__ unsigned xb_add(unsigned* p, unsigned v) { return __hip_atomic_fetch_add(p, v, __ATOMIC_RELAXED, __HIP_MEMORY_SCOPE_AGENT); }
__device__ __forceinline__ unsigned xb_xcc_id() { return (unsigned)__builtin_amdgcn_s_getreg((3 << 11) | 20) & 0xFu; }
#define XB_SPIN(cond, bar) do { unsigned _sp = 0; while (cond) { __builtin_amdgcn_s_sleep(1); \
    if ((++_sp & 255u) == 0u) { if (xb_ld(&(bar)[XB_TMO])) break; if (_sp > XB_SPIN_CAP) { atomicAdd(&(bar)[XB_TMO], 1u); break; } } } } while (0)

struct XcdBarrier {
    unsigned* bar; unsigned x;
    volatile LAS unsigned* st;
};

__device__ __forceinline__ XcdBarrier xcd_barrier_post(unsigned* bar, volatile LAS unsigned* st) {
    XcdBarrier b; b.bar = bar; b.x = xb_xcc_id(); b.st = st;
    if (threadIdx.x == 0) (void)xb_add(&bar[XB_XCNT(b.x)], 1u);
    return b;
}
__device__ __forceinline__ void xcd_barrier_complete(unsigned* bar, unsigned x, unsigned& nloc, unsigned& nx) {
    const unsigned G = gridDim.x * gridDim.y * gridDim.z;
    unsigned sum, cnt, mine, sp = 0u;
    for (;;) {
        sum = 0u; cnt = 0u; mine = 0u;
#pragma unroll
        for (unsigned j = 0; j < 16; ++j) { const unsigned c = xb_ld(&bar[XB_XCNT(j)]); sum += c; cnt += (c > 0u) ? 1u : 0u; mine = (j == x) ? c : mine; }
        if (sum == G) break;
        __builtin_amdgcn_s_sleep(1);
        if ((++sp & 255u) == 0u) { if (xb_ld(&bar[XB_TMO])) break; if (sp > XB_SPIN_CAP) { atomicAdd(&bar[XB_TMO], 1u); break; } }
    }
    nloc = mine > 0u ? mine : 1u; nx = cnt > 0u ? cnt : 1u;
}

__device__ __forceinline__ void xcd_barrier(const XcdBarrier& b) {
    asm volatile("s_waitcnt vmcnt(0)" ::: "memory");
    __syncthreads();
    if (threadIdx.x == 0) {
        unsigned* bar = b.bar;
        __builtin_amdgcn_s_waitcnt(0);
        unsigned nloc = b.st[0], nx = b.st[1];
        if (nloc == 0u) { xcd_barrier_complete(bar, b.x, nloc, nx); b.st[0] = nloc; b.st[1] = nx; }
        const unsigned old = xb_add(&bar[XB_XSUB(b.x)], 1u);
        const unsigned gen = old / nloc;
        if (old + 1u == (gen + 1u) * nloc) {
            __builtin_amdgcn_fence(__ATOMIC_RELEASE, "agent");
            asm volatile("s_waitcnt vmcnt(0)" ::: "memory");
            const unsigned og = xb_add(&bar[XB_TOP], 1u);
            const unsigned tg = og / nx;
            if (og + 1u == (tg + 1u) * nx) xb_add(&bar[XB_TOPGEN], 1u);
            else XB_SPIN(xb_ld(&bar[XB_TOPGEN]) == tg, bar);
            __builtin_amdgcn_fence(__ATOMIC_ACQUIRE, "agent");
            xb_add(&bar[XB_XGEN(b.x)], 1u);
            asm volatile("s_waitcnt vmcnt(0)" ::: "memory");
        } else {
            XB_SPIN(xb_ld(&bar[XB_XGEN(b.x)]) == gen, bar);
            __builtin_amdgcn_fence(__ATOMIC_ACQUIRE, "agent");
            asm volatile("s_waitcnt vmcnt(0)" ::: "memory");
        }
    }
    __syncthreads();
}


#define XB_LOC_ARR(j) (XCD_BAR_WORDS + 64 * (j))
#define XB_LOC_GEN(j) (XCD_BAR_WORDS + 1024 + 64 * (j))
#define XCD_BAR_WORDS_ALL (XCD_BAR_WORDS + 2048)
__device__ __forceinline__ void xcd_local_barrier(const XcdBarrier& b) {
    asm volatile("s_waitcnt vmcnt(0)" ::: "memory");
    __syncthreads();
    if (threadIdx.x == 0) {
        unsigned* bar = b.bar;
        __builtin_amdgcn_s_waitcnt(0);
        const unsigned nloc = b.st[0];
        const unsigned old = xb_add(&bar[XB_LOC_ARR(b.x)], 1u), gen = old / nloc;
        if (old + 1u == (gen + 1u) * nloc) xb_add(&bar[XB_LOC_GEN(b.x)], 1u);
        else XB_SPIN(xb_ld(&bar[XB_LOC_GEN(b.x)]) == gen, bar);
        __builtin_amdgcn_fence(__ATOMIC_ACQUIRE, "agent");
        asm volatile("s_waitcnt vmcnt(0)" ::: "memory");
    }
    __syncthreads();
}

struct Args {
    const float *xp, *xs, *g_mix, *w_in, *g_q, *g_k, *sink, *g_v_ln, *b_v_ln, *w_sp, *b_sp, *g_ao, *g_go, *w_out, *g_ffn, *w_up, *w_down;
    float* out; unsigned char* ws;
};

__device__ __forceinline__ void transpose_tile(const float* __restrict__ W, int K, int N, bf16* __restrict__ WT, const float* __restrict__ ga, const float* __restrict__ gb, int gsplit, LAS float* scr, int item, int lane) {
    const int nkb = K / 64, nb = item / nkb, kb = item % nkb, k0 = 64 * kb, n0 = 64 * nb;
    const int c = lane & 15, kq = lane >> 4;
    f32x4 v[16];
#pragma unroll
    for (int i = 0; i < 16; ++i) v[i] = __builtin_nontemporal_load((const f32x4*)(W + (size_t)(k0 + 4 * i + kq) * N + n0 + 4 * c));
#pragma unroll
    for (int i = 0; i < 16; ++i) {
        const int k = k0 + 4 * i + kq; float g = 1.0f; if (ga) g = (k < gsplit) ? ga[k] : gb[k - gsplit];
        LAS float* p = scr + (4 * i + kq) * 65 + 4 * c; p[0] = v[i][0] * g; p[1] = v[i][1] * g; p[2] = v[i][2] * g; p[3] = v[i][3] * g;
    }
    LDS_WAIT(); asm volatile("" ::: "memory");
    const int kc = lane & 7;
#pragma unroll
    for (int j = 0; j < 8; ++j) { const int n = (lane >> 3) + 8 * j; const LAS float* sp = scr + (8 * kc) * 65 + n;
        v4u o; o.x = pk2(sp[0 * 65], sp[1 * 65]); o.y = pk2(sp[2 * 65], sp[3 * 65]); o.z = pk2(sp[4 * 65], sp[5 * 65]); o.w = pk2(sp[6 * 65], sp[7 * 65]);
        *(v4u*)(WT + (size_t)(n0 + n) * K + k0 + 8 * kc) = o; }
    LDS_WAIT(); asm volatile("" ::: "memory");
}

__device__ __forceinline__ bf16x8 tr_frag(const LAS unsigned char* p0, const LAS unsigned char* p1) {
    const s16x4 a = __builtin_amdgcn_ds_read_tr16_b64_v4i16((LAS s16x4*)p0);
    const s16x4 b = __builtin_amdgcn_ds_read_tr16_b64_v4i16((LAS s16x4*)p1);
    return __builtin_shufflevector(a, b, 0, 1, 2, 3, 4, 5, 6, 7);
}
__device__ __forceinline__ void tile_ld(v4u (&raw)[4], const bf16* proj, int tok0, int colbase, int tid) {
    const int c = tid & 15, r0 = tid >> 4;
#pragma unroll
    for (int p = 0; p < 4; ++p) raw[p] = *(const v4u*)(proj + (size_t)(tok0 + r0 + 32 * p) * INW + colbase + 8 * c);
}
template <int STRIDE> __device__ __forceinline__ void tile_st(const v4u (&raw)[4], LAS unsigned char* dst, int tid) {
    const int c = tid & 15, r0 = tid >> 4;
#pragma unroll
    for (int p = 0; p < 4; ++p) *(LAS v4u*)(dst + (r0 + 32 * p) * STRIDE + c * 16) = raw[p];
}

__device__ __forceinline__ void attn_unit(const bf16* proj, unsigned char* ws, LAS unsigned char* lds, int a) {
    int tid = threadIdx.x; asm volatile("" : "+v"(tid)); const int lane = tid & 63, wave = __builtin_amdgcn_readfirstlane(tid >> 6);
    const float* par = (const float*)(ws + WS_PAR);
    bf16* mix = (bf16*)(ws + WS_MIX); float* ssmix = (float*)(ws + WS_SSMIX);
    const int gb = a >> 2, kvh = (a >> 1) & 1, hp = a & 1;
    int n, nb; if (gb < 64) { nb = 32; n = gb & 31; } else { nb = 16; n = (gb - 64) & 15; }
    const int tok0 = gb * 128, hw = wave >> 2, rq = wave & 3, fr = lane & 15, fq = lane >> 4;
    const int h0 = kvh * 4 + hp * 2, h = h0 + hw;
    LAS unsigned char* QS = lds + LQ; LAS unsigned char* KS = lds + LK; LAS unsigned char* VS = lds + LV;
    const int kb0 = (n > 0) ? n - 1 : 0, kb1 = (n + 1 < nb) ? n + 1 : nb - 1;
    v4u kr[4], vr[4];
    {
        v4u q0[4], q1[4];
        tile_ld(q0, proj, tok0, C_Q + h0 * 128, tid); tile_ld(q1, proj, tok0, C_Q + (h0 + 1) * 128, tid);
        tile_ld(kr, proj, tok0 + (kb0 - n) * 128, C_K + kvh * 128, tid); tile_ld(vr, proj, tok0 + (kb0 - n) * 128, C_V + kvh * 128, tid);
        __syncthreads();
        tile_st<QK_STRIDE>(q0, QS, tid); tile_st<QK_STRIDE>(q1, QS + 128 * QK_STRIDE, tid);
    }
    const LAS unsigned char* qbase = QS + hw * (128 * QK_STRIDE) + (rq * 32 + fr) * QK_STRIDE + (8 * fq) * 2;
    const float sk2 = par[PAR_SINK + h] * LOG2E;
    float mrow[2], lrow[2]; mrow[0] = mrow[1] = sk2; lrow[0] = lrow[1] = (fq == 0) ? 1.0f : 0.0f;
    f32x4 O[2][8];
#pragma unroll
    for (int rt = 0; rt < 2; ++rt)
#pragma unroll
        for (int dt = 0; dt < 8; ++dt) O[rt][dt] = (f32x4){0.f, 0.f, 0.f, 0.f};
#pragma unroll 1
    for (int kb = kb0; kb <= kb1; ++kb) {
        if (kb != kb0) __syncthreads();
        tile_st<QK_STRIDE>(kr, KS, tid); tile_st<V_STRIDE>(vr, VS, tid);
        __syncthreads();
        if (kb < kb1) { tile_ld(kr, proj, tok0 + (kb + 1 - n) * 128, C_K + kvh * 128, tid); tile_ld(vr, proj, tok0 + (kb + 1 - n) * 128, C_V + kvh * 128, tid); }
        f32x4 st[2][8];
#pragma unroll
        for (int kt = 0; kt < 8; ++kt) { st[0][kt] = (f32x4){0.f, 0.f, 0.f, 0.f}; st[1][kt] = (f32x4){0.f, 0.f, 0.f, 0.f}; }
#pragma unroll
        for (int s = 0; s < 4; ++s) {
            const bf16x8 qa = *(const LAS bf16x8*)(qbase + 64 * s), qb = *(const LAS bf16x8*)(qbase + 16 * QK_STRIDE + 64 * s);
#pragma unroll
            for (int kt = 0; kt < 8; ++kt) {
                const bf16x8 kf = *(const LAS bf16x8*)(KS + (16 * kt + fr) * QK_STRIDE + (32 * s + 8 * fq) * 2);
                st[0][kt] = __builtin_amdgcn_mfma_f32_16x16x32_bf16(kf, qa, st[0][kt], 0, 0, 0);
                st[1][kt] = __builtin_amdgcn_mfma_f32_16x16x32_bf16(kf, qb, st[1][kt], 0, 0, 0);
            }
        }
        bf16x8 pb[2][4];
#pragma unroll
        for (int rt = 0; rt < 2; ++rt) {
            const int qi = rq * 32 + rt * 16 + fr;
            if (kb != n) {
                const int sgn = (kb < n) ? 1 : -1, dbase = sgn * (4 * fq - qi);
#pragma unroll
                for (int kt = 0; kt < 8; ++kt)
#pragma unroll
                    for (int r = 0; r < 4; ++r) { const int dd = dbase + sgn * (16 * kt + r); st[rt][kt][r] += __builtin_bit_cast(float, (unsigned)(dd >> 31) & 0xF149F2CAu); }
            }
            float mx = -1e30f;
#pragma unroll
            for (int kt = 0; kt < 8; ++kt)
#pragma unroll
                for (int r = 0; r < 4; ++r) mx = fmaxf(mx, st[rt][kt][r]);
            mx = fmaxf(mx, __shfl_xor(mx, 16)); mx = fmaxf(mx, __shfl_xor(mx, 32));
            const float mnew = fmaxf(mrow[rt], mx), alpha = __builtin_amdgcn_exp2f(mrow[rt] - mnew);
            mrow[rt] = mnew; float ls = lrow[rt] * alpha;
#pragma unroll
            for (int dt = 0; dt < 8; ++dt) O[rt][dt] *= alpha;
#pragma unroll
            for (int kt = 0; kt < 8; ++kt)
#pragma unroll
                for (int r = 0; r < 4; ++r) { const float p = __builtin_amdgcn_exp2f(st[rt][kt][r] - mnew); st[rt][kt][r] = p; ls += p; }
            lrow[rt] = ls;
#pragma unroll
            for (int tp = 0; tp < 4; ++tp) {
                v4u w; w.x = pk2(st[rt][2 * tp][0], st[rt][2 * tp][1]); w.y = pk2(st[rt][2 * tp][2], st[rt][2 * tp][3]);
                w.z = pk2(st[rt][2 * tp + 1][0], st[rt][2 * tp + 1][1]); w.w = pk2(st[rt][2 * tp + 1][2], st[rt][2 * tp + 1][3]);
                pb[rt][tp] = __builtin_bit_cast(bf16x8, w);
            }
        }
#pragma unroll
        for (int dt = 0; dt < 8; ++dt)
#pragma unroll
            for (int tp = 0; tp < 4; ++tp) {
                const LAS unsigned char* p0 = VS + (32 * tp + 4 * fq + (fr >> 2)) * V_STRIDE + (16 * dt + 4 * (fr & 3)) * 2;
                const bf16x8 vf = tr_frag(p0, p0 + 16 * V_STRIDE);
                O[0][dt] = __builtin_amdgcn_mfma_f32_16x16x32_bf16(vf, pb[0][tp], O[0][dt], 0, 0, 0);
                O[1][dt] = __builtin_amdgcn_mfma_f32_16x16x32_bf16(vf, pb[1][tp], O[1][dt], 0, 0, 0);
            }
    }
#pragma unroll
    for (int rt = 0; rt < 2; ++rt) {
        float lt = lrow[rt]; lt += __shfl_xor(lt, 16); lt += __shfl_xor(lt, 32);
        const float inv = 1.0f / lt; const int tok = tok0 + rq * 32 + rt * 16 + fr; float ss = 0.f;
        bf16* orow = mix + (size_t)tok * D + h * 128 + 4 * fq;
#pragma unroll
        for (int dt = 0; dt < 8; ++dt) { const f32x4 o = O[rt][dt] * inv; ss += (o[0] * o[0] + o[1] * o[1]) + (o[2] * o[2] + o[3] * o[3]);
            v2u w; w.x = pk2(o[0], o[1]); w.y = pk2(o[2], o[3]); *(v2u*)(orow + 16 * dt) = w; }
        ss += __shfl_xor(ss, 16); ss += __shfl_xor(ss, 32);
        if (fq == 0) unsafeAtomicAdd(ssmix + (size_t)tok * 2, ss);
    }
}

__device__ __forceinline__ void gmlp_unit(const bf16* proj, unsigned char* ws, LAS unsigned char* lds, int gu) {
    int tid = threadIdx.x; asm volatile("" : "+v"(tid)); const int lane = tid & 63, wave = __builtin_amdgcn_readfirstlane(tid >> 6);
    const float* par = (const float*)(ws + WS_PAR);
    const float* lnstat = (const float*)(ws + WS_LNSTAT); const bf16* wsp = (const bf16*)(ws + WS_WSP);
    bf16* mix = (bf16*)(ws + WS_MIX); float* ssmix = (float*)(ws + WS_SSMIX);
    const int gb = gu >> 3, h = gu & 7, tok0 = gb * 128, fr = lane & 15, fq = lane >> 4;
    LAS unsigned char* VN = lds;
    const int c = tid & 15, r0 = tid >> 4;
    v4u raw[4]; f32x2 stv[4];
    tile_ld(raw, proj, tok0, C_VG + h * 128, tid);
#pragma unroll
    for (int p = 0; p < 4; ++p) stv[p] = *(const f32x2*)(lnstat + 2 * (tok0 + r0 + 32 * p));
    const f32x4 g0 = *(const f32x4*)(par + PAR_GV + h * 128 + 8 * c), g1 = *(const f32x4*)(par + PAR_GV + h * 128 + 8 * c + 4);
    const f32x4 b0 = *(const f32x4*)(par + PAR_BV + h * 128 + 8 * c), b1 = *(const f32x4*)(par + PAR_BV + h * 128 + 8 * c + 4);
    bf16x8 wf[4];
#pragma unroll
    for (int s = 0; s < 4; ++s) wf[s] = *(const bf16x8*)(wsp + ((size_t)(h * 128 + 16 * wave + fr) * 128 + 32 * s + 8 * fq));
    const int tok = tok0 + 16 * wave + fr; const float bsp = par[PAR_BSP + h * 128 + 16 * wave + fr];
    const bf16* urow = proj + (size_t)tok * INW + C_U + h * 128 + 4 * fq; bf16* orow = mix + (size_t)tok * D + 1024 + h * 128 + 4 * fq;
    v2u uw[8];
#pragma unroll
    for (int ct = 0; ct < 8; ++ct) uw[ct] = *(const v2u*)(urow + 16 * ct);
    __syncthreads();
#pragma unroll
    for (int p = 0; p < 4; ++p) {
        const float mu = stv[p][0] * (1.0f / 1024.0f), var = fmaxf(stv[p][1] * (1.0f / 1024.0f) - mu * mu, 0.f), rstd = 1.0f / sqrtf(var + pg8::EPSN);
        float v[8];
        v[0] = bflo(raw[p].x); v[1] = bfhi(raw[p].x); v[2] = bflo(raw[p].y); v[3] = bfhi(raw[p].y); v[4] = bflo(raw[p].z); v[5] = bfhi(raw[p].z); v[6] = bflo(raw[p].w); v[7] = bfhi(raw[p].w);
#pragma unroll
        for (int e = 0; e < 4; ++e) { v[e] = (v[e] - mu) * rstd * g0[e] + b0[e]; v[4 + e] = (v[4 + e] - mu) * rstd * g1[e] + b1[e]; }
        v4u o; o.x = pk2(v[0], v[1]); o.y = pk2(v[2], v[3]); o.z = pk2(v[4], v[5]); o.w = pk2(v[6], v[7]);
        *(LAS v4u*)(VN + (r0 + 32 * p) * V_STRIDE + c * 16) = o;
    }
    __syncthreads();
    f32x4 acc[8];
#pragma unroll
    for (int ct = 0; ct < 8; ++ct) {
        acc[ct] = (f32x4){0.f, 0.f, 0.f, 0.f};
#pragma unroll
        for (int s = 0; s < 4; ++s) {
            const LAS unsigned char* p0 = VN + (32 * s + 8 * fq + (fr >> 2)) * V_STRIDE + (16 * ct + 4 * (fr & 3)) * 2;
            const bf16x8 vf = tr_frag(p0, p0 + 4 * V_STRIDE);
            acc[ct] = __builtin_amdgcn_mfma_f32_16x16x32_bf16(vf, wf[s], acc[ct], 0, 0, 0);
        }
    }
    float ss = 0.f;
#pragma unroll
    for (int ct = 0; ct < 8; ++ct) {
        const float o0 = bflo(uw[ct].x) * (acc[ct][0] + bsp), o1 = bfhi(uw[ct].x) * (acc[ct][1] + bsp), o2 = bflo(uw[ct].y) * (acc[ct][2] + bsp), o3 = bfhi(uw[ct].y) * (acc[ct][3] + bsp);
        ss += (o0 * o0 + o1 * o1) + (o2 * o2 + o3 * o3);
        v2u w; w.x = pk2(o0, o1); w.y = pk2(o2, o3); *(v2u*)(orow + 16 * ct) = w;
    }
    ss += __shfl_xor(ss, 16); ss += __shfl_xor(ss, 32);
    if (fq == 0) unsafeAtomicAdd(ssmix + (size_t)tok * 2 + 1, ss);
}

__device__ __forceinline__ void convert_out_down(const Args& A, LAS unsigned char* lds, int vcu, int G) {
    int tid = threadIdx.x; asm volatile("" : "+v"(tid)); const int lane = tid & 63, wave = __builtin_amdgcn_readfirstlane(tid >> 6);
    unsigned char* ws = A.ws;
    __syncthreads();
    LAS float* scr = (LAS float*)(lds + wave * 16640);
    constexpr int I_OUT0 = (D / 64) * (D / 64), I_DN0 = (FF / 64) * (D / 64);
    for (int it = vcu * NW + wave; it < I_OUT0 + I_DN0; it += G * NW) {
        if (it < I_OUT0) transpose_tile(A.w_out, D, D, (bf16*)(ws + WS_WOUT), A.g_ao, A.g_go, 1024, scr, it, lane);
        else transpose_tile(A.w_down, FF, D, (bf16*)(ws + WS_WDOWN), nullptr, nullptr, 0, scr, it - I_OUT0, lane);
    }
    __syncthreads();
}

template <int HF> __device__ __forceinline__ void ffn_half(const Args& A, LAS unsigned char* lds, int G, int bx, const XcdBarrier& xb, bool hwx) {
    unsigned char* ws = A.ws;
    bf16* HID = (bf16*)(ws + WS_HID);
    {
        pg8::Gemm g{(const bf16*)(ws + WS_XB) + (size_t)HF * TH * D, (const bf16*)(ws + WS_WUP), TH, FF, D, D}; pg8::StaticOrder S; S.init(TH, FF, G, bx, 4);
        pg8::EpiUp E{HID, (const float*)(ws + WS_SS2) + HF * TH};
        pg8::gemm_phase<pg8::EpiUp, pg8::StaticOrder, true, true>(lds, g, S, E);
    }
    if (hwx) xcd_local_barrier(xb); else xcd_barrier(xb);
    {
        pg8::Gemm g{HID, (const bf16*)(ws + WS_WDOWN), TH, D, FF, FF}; pg8::StaticOrder S; S.init(TH, D, G, bx, 4);
        pg8::EpiDown E{A.out + (size_t)HF * TH * D, (const bf16*)(ws + WS_XB) + (size_t)HF * TH * D};
        pg8::gemm_phase<pg8::EpiDown, pg8::StaticOrder, true, true>(lds, g, S, E);
    }
}

__global__ void __launch_bounds__(NT, 2) fwd_mega(Args A) {
    extern __shared__ __attribute__((aligned(16))) unsigned char lds_raw[];
    LAS unsigned char* lds = (LAS unsigned char*)lds_raw;
    cg::grid_group grid = cg::this_grid();
    const int tid = threadIdx.x, lane = tid & 63, wave = __builtin_amdgcn_readfirstlane(tid >> 6);
    const int G = gridDim.x, bx = blockIdx.x;
    const int vcu = (G % 8 == 0) ? (bx % 8) * (G / 8) + bx / 8 : bx;
    unsigned char* ws = A.ws;
    bf16* WinT = (bf16*)(ws + WS_WIN); bf16* WoutT = (bf16*)(ws + WS_WOUT); bf16* WupT = (bf16*)(ws + WS_WUP); bf16* WdownT = (bf16*)(ws + WS_WDOWN);
    bf16* XB = (bf16*)(ws + WS_XB); bf16* HID = (bf16*)(ws + WS_HID); bf16* MIX = (bf16*)(ws + WS_MIX);
    float* lnstat = (float*)(ws + WS_LNSTAT); float* ss2 = (float*)(ws + WS_SS2); float* r1 = (float*)(ws + WS_R1); float* ssmix = (float*)(ws + WS_SSMIX);
    bf16* PROJ = (bf16*)A.out;
    if (tid < 2) ((LAS unsigned*)(lds + LDS_BARST))[tid] = 0u;
    unsigned* barw = (unsigned*)(ws + WS_BAR);
    if (bx == 0) for (int i = tid; i < XCD_BAR_WORDS_ALL; i += NT) barw[i] = 0u;
    grid.sync();
    XcdBarrier xbar; xbar.bar = barw; xbar.x = xb_xcc_id(); xbar.st = (volatile LAS unsigned*)(lds + LDS_BARST);
    if (tid == 0) ((LAS unsigned*)(lds + LDS_BARST))[2] = xb_add(&barw[XB_XCNT(xbar.x)], 1u);

    {
        const int gw = vcu * NW + wave, NGW = G * NW;
        LAS float* scr = (LAS float*)(lds + wave * 16640);
        constexpr int I_IN = (D / 64) * (INW / 64);
        for (int it = gw; it < I_IN; it += NGW) transpose_tile(A.w_in, D, INW, WinT, A.g_mix, A.g_mix, D, scr, it, lane);
        for (int m = gw; m < T; m += NGW) {
            const float* xrow = (m < 8192) ? A.xp + (size_t)m * D : A.xs + (size_t)(m - 8192) * D;
            const f32x4* xr = (const f32x4*)xrow + lane; f32x4 v[8]; float s = 0.f;
#pragma unroll
            for (int j = 0; j < 8; ++j) { v[j] = __builtin_nontemporal_load(xr + 64 * j); s += (v[j][0] * v[j][0] + v[j][1] * v[j][1]) + (v[j][2] * v[j][2] + v[j][3] * v[j][3]); }
            s = wave_sum(s);
            if (lane == 0) r1[m] = 1.0f / sqrtf(s * (1.0f / D) + pg8::EPSN);
            v2u* o8 = (v2u*)(XB + (size_t)m * D) + lane;
#pragma unroll
            for (int j = 0; j < 8; ++j) { v2u w; w.x = pk2(v[j][0], v[j][1]); w.y = pk2(v[j][2], v[j][3]); o8[64 * j] = w; }
        }
        const int gt = vcu * NT + tid, NGT = G * NT;
        for (int i = gt; i < 8 * 128 * 128; i += NGT) ((bf16*)(ws + WS_WSP))[i] = (bf16)f2bf(A.w_sp[i]);
        for (int i = gt; i < 4096 * 16; i += NGT) {
            const int pos = i >> 4, k = i & 15;
            const float inv_freq = __builtin_amdgcn_exp2f(-(float)k * (18.931568569324174f / 16.0f));
            const float ang = (float)pos * inv_freq, rev = ang * 0.15915494309189535f, fr = rev - floorf(rev);
            float* tp = (float*)(ws + WS_TAB) + 2 * (size_t)i; tp[0] = __builtin_amdgcn_cosf(fr); tp[1] = __builtin_amdgcn_sinf(fr);
        }
        for (int i = gt; i < PAR_N; i += NGT) {
            float v = 0.f;
            if (i < PAR_GK) v = A.g_q[i]; else if (i < PAR_SINK) v = A.g_k[i - PAR_GK]; else if (i < PAR_SINK + 8) v = A.sink[i - PAR_SINK];
            else if (i < PAR_GV) v = 0.f; else if (i < PAR_BV) v = A.g_v_ln[i - PAR_GV]; else if (i < PAR_BSP) v = A.b_v_ln[i - PAR_BV]; else v = A.b_sp[i - PAR_BSP];
            ((float*)(ws + WS_PAR))[i] = v;
        }
        for (int i = gt; i < 2 * T; i += NGT) { lnstat[i] = 0.f; ssmix[i] = 0.f; }
        for (int i = gt; i < T; i += NGT) ss2[i] = 0.f;
    }
    xcd_barrier(xbar);
    if (tid == 0) {
        bool ok = (G % 8 == 0);
        for (unsigned j = 0; j < 16; ++j) { const unsigned cj = xb_ld(&barw[XB_XCNT(j)]); ok = ok && ((j < 8) ? (cj == (unsigned)(G / 8)) : (cj == 0u)); }
        LAS unsigned* st = (LAS unsigned*)(lds + LDS_BARST); st[3] = ok ? (st[2] * 8u + xbar.x) : (unsigned)bx; st[4] = ok ? 1u : 0u;
    }
    __syncthreads();
    const int cid = __builtin_amdgcn_readfirstlane((int)((LAS unsigned*)(lds + LDS_BARST))[3]);
    const int vcu2 = (G % 8 == 0) ? (cid % 8) * (G / 8) + cid / 8 : cid;
    const bool hwx = __builtin_amdgcn_readfirstlane((int)((LAS unsigned*)(lds + LDS_BARST))[4]) != 0;
    {
        pg8::Gemm g{XB, WinT, T, INW, D, D}; pg8::StaticOrder S; S.init(T, INW, G, cid, 4);
        pg8::EpiProj E{PROJ, r1, lnstat, (const float*)(ws + WS_PAR) + PAR_GQ, (const float*)(ws + WS_PAR) + PAR_GK, (const float*)(ws + WS_TAB), (LAS float*)(lds + 131072)};
        pg8::gemm_phase<pg8::EpiProj, pg8::StaticOrder, true, true>(lds, g, S, E);
        constexpr int NU = (T / 256) * (INW / 256);
        const int rem = NU % G, NH = (rem == 0) ? G : G - rem, hi = (rem == 0) ? cid : cid - rem;
        if (hi >= 0) {
            constexpr int I_UP = (D / 64) * (FF / 64);
            LAS float* scr = (LAS float*)(lds + wave * 16640);
            for (int it = hi * NW + wave; it < I_UP; it += NH * NW) transpose_tile(A.w_up, D, FF, WupT, A.g_ffn, A.g_ffn, D, scr, it, lane);
        }
    }
    xcd_barrier(xbar);
    if (!(vcu2 & 1)) convert_out_down(A, lds, vcu2, G);
#pragma unroll 1
    for (int u = vcu2; u < 1536; u += G) {
        if (u < 512) attn_unit(PROJ, ws, lds, u);
        else gmlp_unit(PROJ, ws, lds, u - 512);
    }
    if (vcu2 & 1) convert_out_down(A, lds, vcu2, G);
    xcd_barrier(xbar);
    {
        pg8::Gemm g{MIX, WoutT, T, D, D, D}; pg8::StaticOrder S; S.init(T, D, G, cid, 4);
        LAS pg8::f32x2* sct = (LAS pg8::f32x2*)(lds + 131072);
        for (int e = tid; e < 7 * 256; e += NT) {
            pg8::Unit u; if (!S.next(e >> 8, u)) break;
            const pg8::f32x2 p = *(const pg8::f32x2*)(ssmix + (size_t)(u.pm * 256 + (e & 255)) * 2);
            const float va = p[0] * (1.0f / 1024.0f) + pg8::EPSN, vg = p[1] * (1.0f / 1024.0f) + pg8::EPSN;
            pg8::f32x2 o; o[1] = __builtin_amdgcn_rsqf(vg); o[0] = __builtin_amdgcn_rsqf(va) * __builtin_amdgcn_sqrtf(vg); sct[e] = o;
        }
        __syncthreads();
        pg8::EpiOut E{XB, ss2, sct};
        pg8::gemm_phase<pg8::EpiOut, pg8::StaticOrder, true, true>(lds, g, S, E);
    }
    xcd_barrier(xbar);
    ffn_half<0>(A, lds, G, cid, xbar, hwx);
    if (hwx) xcd_local_barrier(xbar); else xcd_barrier(xbar);
    ffn_half<1>(A, lds, G, cid, xbar, hwx);
}

extern "C" void kernel_launch(void* const* d_in, const int* in_sizes, int n_in, void* d_out, int out_size, void* d_ws, size_t ws_size, hipStream_t stream) {
    static int grid = 0;
    if (grid == 0) {
        if (n_in != 17 || out_size != T * D || ws_size < WS_END) { fprintf(stderr, "kernel_launch: unexpected sizes n_in %d out %d ws %zu (need %zu)\n", n_in, out_size, ws_size, (size_t)WS_END); }
        int dev = 0, cus = 0, per_cu = 0;
        (void)hipGetDevice(&dev); (void)hipDeviceGetAttribute(&cus, hipDeviceAttributeMultiprocessorCount, dev);
        if (hipFuncSetAttribute((const void*)fwd_mega, hipFuncAttributeMaxDynamicSharedMemorySize, LDS_BYTES) != hipSuccess) fprintf(stderr, "kernel_launch: hipFuncSetAttribute failed\n");
        if (hipOccupancyMaxActiveBlocksPerMultiprocessor(&per_cu, (const void*)fwd_mega, NT, LDS_BYTES) != hipSuccess || per_cu < 1) { fprintf(stderr, "kernel_launch: occupancy query gave %d\n", per_cu); per_cu = 1; }
        (void)hipGetLastError();
        if (cus <= 0) cus = 256;
        grid = cus * per_cu;
        fprintf(stderr, "kernel_launch: grid %d (cus %d per_cu %d) ws %zu\n", grid, cus, per_cu, ws_size);
    }
    Args a{};
    a.xp = (const float*)d_in[0]; a.xs = (const float*)d_in[1]; a.g_mix = (const float*)d_in[2]; a.w_in = (const float*)d_in[3]; a.g_q = (const float*)d_in[4]; a.g_k = (const float*)d_in[5];
    a.sink = (const float*)d_in[6]; a.g_v_ln = (const float*)d_in[7]; a.b_v_ln = (const float*)d_in[8]; a.w_sp = (const float*)d_in[9]; a.b_sp = (const float*)d_in[10];
    a.g_ao = (const float*)d_in[11]; a.g_go = (const float*)d_in[12]; a.w_out = (const float*)d_in[13]; a.g_ffn = (const float*)d_in[14]; a.w_up = (const float*)d_in[15]; a.w_down = (const float*)d_in[16];
    a.out = (float*)d_out; a.ws = (unsigned char*)d_ws;
    void* args[] = {&a};
    hipError_t e = hipLaunchCooperativeKernel((const void*)fwd_mega, dim3(grid), dim3(NT), args, LDS_BYTES, stream);
    if (e != hipSuccess) fprintf(stderr, "kernel_launch: cooperative launch failed: %s (grid %d)\n", hipGetErrorString(e), grid);
}
```

```cpp
#include <hip/hip_runtime.h>
#include <hip/hip_cooperative_groups.h>
#include <cstdio>
#include <cstdint>
namespace cg = cooperative_groups;
namespace pg8 {
#define PG8_LAS __attribute__((address_space(3)))
typedef unsigned short bf16_t;
typedef short bf16x8 __attribute__((ext_vector_type(8)));
typedef float f32x4 __attribute__((ext_vector_type(4)));
typedef unsigned u32x4 __attribute__((ext_vector_type(4)));
constexpr int BM = 256, BK = 64, HALF = 128, HTB = HALF * BK * 2  , STAGE_BYTES = 8 * HTB, NXCD = 8, WGM = 8;

__host__ __device__ __forceinline__ int lds_byte(int r, int c) { const int st = (r >> 4) * 2 + (c >> 5), rr = r & 15, cc = c & 31, ob = rr * 64 + cc * 2; return st * 1024 + (ob ^ (((ob >> 9) & 1) << 5)); }
__host__ __device__ __forceinline__ void stage_rc(int b, int& R, int& C) { const int st = b / 1024, sb = b % 1024, swz = sb ^ (((sb >> 9) & 1) << 5); R = (st >> 1) * 16 + swz / 64; C = (st & 1) * 32 + (swz % 64) / 2; }
__host__ __device__ __forceinline__ int perm32(int rho) { const int n = rho >> 4, i = rho & 15; return 8 * (i >> 2) + 4 * n + (i & 3); }

struct Unit { int pm, pn, kh, slot; };
struct Gemm { const bf16_t* A; const bf16_t* Bt; int M, N, K, ld; };

struct StaticOrder {
    int nM, nN, nwg, G, c, wgm; bool halves;
    __host__ __device__ void init(int M, int N, int G_, int c_, int wgm_ = WGM, bool halves_ = false) { nM = M / BM; nN = N / BM; nwg = nM * nN; G = G_; c = c_; wgm = wgm_; halves = halves_; }
    __host__ __device__ bool next(int i, Unit& u) const {
        const long L = (long)i * G + c; if (L >= nwg) return false;
        int wgid = (int)L; { const int q = nwg / NXCD, r = nwg % NXCD, xcd = wgid % NXCD, off = wgid / NXCD; wgid = (xcd < r ? xcd * (q + 1) : r * (q + 1) + (xcd - r) * q) + off; }
        const int nig = wgm * nN, gid = wgid / nig, fm = gid * wgm, gsz = (nM - fm) < wgm ? (nM - fm) : wgm;
        u.pm = fm + ((wgid % nig) % gsz); u.pn = (wgid % nig) / gsz; if (halves) { const int x = u.pm >> 3, j = u.pm & 7; u.pm = (j >> 2) * 32 + 4 * x + (j & 3); } u.kh = 0; u.slot = i; return true;
    }
    __device__ __forceinline__ void a_ready(const Unit&) const {}
    __device__ __forceinline__ void done(const Unit&) const {}
};
__device__ __forceinline__ unsigned cvt_pk_bf16(float lo, float hi) { unsigned r; asm volatile("v_cvt_pk_bf16_f32 %0, %1, %2" : "=v"(r) : "v"(lo), "v"(hi)); return r; }
struct SplitOrder : StaticOrder {
    __host__ __device__ bool next(int i, Unit& u) const { if (!StaticOrder::next(i >> 1, u)) return false; u.kh = i & 1; u.slot = i >> 1; return true; }
};
typedef float f32x2 __attribute__((ext_vector_type(2)));
typedef unsigned u32x2 __attribute__((ext_vector_type(2)));
__device__ __forceinline__ float gelu_tanh(float x) {
    const float t = x * x * 0.044715f + 1.0f;
    const float e = __builtin_amdgcn_exp2f(x * t * (-2.0f * 0.7978845608028654f * 1.4426950408889634f));
    return x * __builtin_amdgcn_rcpf(1.0f + e);
}
constexpr int PROJ_LD = 3584, DM = 2048, DFF = 8192;
constexpr float EPSN = 1e-6f;

struct EpiProj {
    static constexpr bool PERM = true, AFTER_DRAIN = false, MID = false, MIDLOOP = false;
    bf16_t* O; const float* r1; float* lnstat; const float* gq; const float* gk; const float* tab; PG8_LAS float* xch;
    __device__ __forceinline__ void operator()(const f32x4 (&acc)[2][2][4][2], const Unit& u, int wr, int wc, int fr, int fq) const {
        const int row0 = u.pm * BM + wr * 64 + fr, col0 = u.pn * BM + wc * 32 + 8 * fq;
        if (u.pn <= 4) {
            float rsv[2][4];
#pragma unroll
            for (int ai = 0; ai < 2; ++ai)
#pragma unroll
                for (int m = 0; m < 4; ++m) {
                    const float rs = r1[row0 + ai * HALF + m * 16]; rsv[ai][m] = rs;
#pragma unroll
                    for (int bj = 0; bj < 2; ++bj) {
                        const f32x4 v0 = acc[ai][bj][m][0] * rs, v1 = acc[ai][bj][m][1] * rs;
                        float s = (v0[0] * v0[0] + v0[1] * v0[1]) + (v0[2] * v0[2] + v0[3] * v0[3]) + (v1[0] * v1[0] + v1[1] * v1[1]) + (v1[2] * v1[2] + v1[3] * v1[3]);
                        s += __shfl_xor(s, 16); s += __shfl_xor(s, 32);
                        if (fq == 0) xch[((((wr * 4 + wc) * 2 + ai) * 4 + m) * 2 + bj) * 16 + fr] = s;
                    }
                }
            asm volatile("s_waitcnt lgkmcnt(0)" ::: "memory"); __builtin_amdgcn_s_barrier(); asm volatile("" ::: "memory");
            const bool isq = u.pn < 4; const float* gp = (isq ? gq : gk) + wc * 32 + 8 * fq;
            const f32x4 g0 = *(const f32x4*)gp, g1 = *(const f32x4*)(gp + 4);
            const float osc = isq ? 0.08838834764831845f * 1.4426950408889634f : 1.0f;
#pragma unroll
            for (int ai = 0; ai < 2; ++ai)
#pragma unroll
                for (int m = 0; m < 4; ++m) {
                    const int row = row0 + ai * HALF + m * 16; const float rs = rsv[ai][m];
                    bf16_t* rowp = O + (size_t)row * PROJ_LD + col0;
                    f32x4 c0 = {0.f, 0.f, 0.f, 0.f}, c1 = c0, c2 = c0, c3 = c0;
                    if (wc == 0) { const int pos = (row < 8192) ? (row & 4095) : (row & 2047); const f32x4* tp = (const f32x4*)(tab + ((size_t)pos * 16 + 8 * (fq & 1)) * 2); c0 = tp[0]; c1 = tp[1]; c2 = tp[2]; c3 = tp[3]; }
#pragma unroll
                    for (int bj = 0; bj < 2; ++bj) {
                        float tot = 0.f;
#pragma unroll
                        for (int w = 0; w < 4; ++w) tot += xch[((((wr * 4 + w) * 2 + ai) * 4 + m) * 2 + bj) * 16 + fr];
                        const float sc = rs * __builtin_amdgcn_rsqf(tot * (1.0f / 128.0f) + EPSN);
                        f32x4 v0 = acc[ai][bj][m][0] * sc * g0, v1 = acc[ai][bj][m][1] * sc * g1;
                        if (wc == 0) {
                            f32x4 p0, p1;
#pragma unroll
                            for (int j = 0; j < 4; ++j) { p0[j] = __shfl_xor(v0[j], 32); p1[j] = __shfl_xor(v1[j], 32); }
                            const float sg = (fq < 2) ? -1.0f : 1.0f;
                            v0[0] = v0[0] * c0[0] + sg * p0[0] * c0[1]; v0[1] = v0[1] * c0[2] + sg * p0[1] * c0[3]; v0[2] = v0[2] * c1[0] + sg * p0[2] * c1[1]; v0[3] = v0[3] * c1[2] + sg * p0[3] * c1[3];
                            v1[0] = v1[0] * c2[0] + sg * p1[0] * c2[1]; v1[1] = v1[1] * c2[2] + sg * p1[1] * c2[3]; v1[2] = v1[2] * c3[0] + sg * p1[2] * c3[1]; v1[3] = v1[3] * c3[2] + sg * p1[3] * c3[3];
                        }
                        v0 *= osc; v1 *= osc;
                        u32x4 w; w.x = cvt_pk_bf16(v0[0], v0[1]); w.y = cvt_pk_bf16(v0[2], v0[3]); w.z = cvt_pk_bf16(v1[0], v1[1]); w.w = cvt_pk_bf16(v1[2], v1[3]);
                        __builtin_nontemporal_store(w, (u32x4*)(rowp + bj * HALF));
                    }
                }
            return;
        }
        const bool act = u.pn >= 6, st = u.pn >= 10;
#pragma unroll
        for (int ai = 0; ai < 2; ++ai)
#pragma unroll
            for (int m = 0; m < 4; ++m) {
                const int row = row0 + ai * HALF + m * 16; const float rs = r1[row];
                bf16_t* rowp = O + (size_t)row * PROJ_LD + col0; float s1 = 0.f, s2 = 0.f;
#pragma unroll
                for (int bj = 0; bj < 2; ++bj) {
                    f32x4 v0 = acc[ai][bj][m][0] * rs, v1 = acc[ai][bj][m][1] * rs;
                    if (act) {
#pragma unroll
                        for (int j = 0; j < 4; ++j) { v0[j] = gelu_tanh(v0[j]); v1[j] = gelu_tanh(v1[j]); }
                    }
                    if (st) {
#pragma unroll
                        for (int j = 0; j < 4; ++j) { s1 += v0[j] + v1[j]; s2 += v0[j] * v0[j] + v1[j] * v1[j]; }
                    }
                    u32x4 w; w.x = cvt_pk_bf16(v0[0], v0[1]); w.y = cvt_pk_bf16(v0[2], v0[3]); w.z = cvt_pk_bf16(v1[0], v1[1]); w.w = cvt_pk_bf16(v1[2], v1[3]);
                    __builtin_nontemporal_store(w, (u32x4*)(rowp + bj * HALF));
                }
                if (st && lnstat) {
                    s1 += __shfl_xor(s1, 16); s1 += __shfl_xor(s1, 32); s2 += __shfl_xor(s2, 16); s2 += __shfl_xor(s2, 32);
                    if (fq == 0) { unsafeAtomicAdd(lnstat + 2 * row, s1); unsafeAtomicAdd(lnstat + 2 * row + 1, s2); }
                }
            }
    }
};
struct EpiOut {
    static constexpr bool PERM = false, AFTER_DRAIN = false, MID = false, MIDLOOP = true;
    bf16_t* x1b; float* ss2; const PG8_LAS f32x2* sct;
    __device__ __forceinline__ void midloop(f32x4 (&acc)[2][2][4][2], const Unit& u, int wr, int fr) const {
        const PG8_LAS f32x2* p = sct + u.slot * 256 + wr * 64 + fr;
#pragma unroll
        for (int ai = 0; ai < 2; ++ai)
#pragma unroll
            for (int m = 0; m < 4; ++m) {
                const float ratio = p[ai * HALF + m * 16][0];
#pragma unroll
                for (int bj = 0; bj < 2; ++bj)
#pragma unroll
                    for (int n = 0; n < 2; ++n) acc[ai][bj][m][n] *= ratio;
            }
    }
    __device__ __forceinline__ void operator()(const f32x4 (&acc)[2][2][4][2], const Unit& u, int wr, int wc, int fr, int fq) const {
        const int row0 = u.pm * BM + wr * 64 + fr, col0 = u.pn * BM + wc * 32 + 4 * fq;
        const PG8_LAS f32x2* p = sct + u.slot * 256 + wr * 64 + fr;
#pragma unroll
        for (int ai = 0; ai < 2; ++ai)
#pragma unroll
            for (int m = 0; m < 4; ++m) {
                const int row = row0 + ai * HALF + m * 16; const float rg = p[ai * HALF + m * 16][1];
                bf16_t* brow = x1b + (size_t)row * DM + col0; float sq = 0.f;
#pragma unroll
                for (int bj = 0; bj < 2; ++bj)
#pragma unroll
                    for (int n = 0; n < 2; ++n) {
                        const u32x2 xw = *(const u32x2*)(brow + bj * HALF + n * 16);
                        f32x4 v = acc[ai][bj][m][n] * rg;
                        v[0] += __builtin_bit_cast(float, xw.x << 16); v[1] += __builtin_bit_cast(float, xw.x & 0xffff0000u); v[2] += __builtin_bit_cast(float, xw.y << 16); v[3] += __builtin_bit_cast(float, xw.y & 0xffff0000u);
                        u32x2 w; w.x = cvt_pk_bf16(v[0], v[1]); w.y = cvt_pk_bf16(v[2], v[3]); *(u32x2*)(brow + bj * HALF + n * 16) = w;
                        sq += (v[0] * v[0] + v[1] * v[1]) + (v[2] * v[2] + v[3] * v[3]);
                    }
                sq += __shfl_xor(sq, 16); sq += __shfl_xor(sq, 32);
                if (fq == 0) unsafeAtomicAdd(ss2 + row, sq);
            }
    }
};
struct EpiUp {
    static constexpr bool PERM = true, AFTER_DRAIN = false, MID = false, MIDLOOP = false;
    bf16_t* H; const float* ss2;
    __device__ __forceinline__ void operator()(const f32x4 (&acc)[2][2][4][2], const Unit& u, int wr, int wc, int fr, int fq) const {
        const int row0 = u.pm * BM + wr * 64 + fr, col0 = u.pn * BM + wc * 32 + 8 * fq;
#pragma unroll
        for (int ai = 0; ai < 2; ++ai)
#pragma unroll
            for (int m = 0; m < 4; ++m) {
                const int row = row0 + ai * HALF + m * 16; const float rs = 1.0f / sqrtf(__hip_atomic_load(ss2 + row, __ATOMIC_RELAXED, __HIP_MEMORY_SCOPE_AGENT) * (1.0f / 2048.0f) + EPSN);
                bf16_t* rowp = H + (size_t)row * DFF + col0;
#pragma unroll
                for (int bj = 0; bj < 2; ++bj) {
                    f32x4 v0 = acc[ai][bj][m][0] * rs, v1 = acc[ai][bj][m][1] * rs;
#pragma unroll
                    for (int j = 0; j < 4; ++j) { v0[j] = fmaxf(v0[j], 0.f); v0[j] *= v0[j]; v1[j] = fmaxf(v1[j], 0.f); v1[j] *= v1[j]; }
                    u32x4 w; w.x = cvt_pk_bf16(v0[0], v0[1]); w.y = cvt_pk_bf16(v0[2], v0[3]); w.z = cvt_pk_bf16(v1[0], v1[1]); w.w = cvt_pk_bf16(v1[2], v1[3]);
                    *(u32x4*)(rowp + bj * HALF) = w;
                }
            }
    }
};
struct EpiDown {
    static constexpr bool PERM = false, AFTER_DRAIN = false, MID = false, MIDLOOP = false;
    float* out; const bf16_t* x1b;
    __device__ __forceinline__ void operator()(const f32x4 (&acc)[2][2][4][2], const Unit& u, int wr, int wc, int fr, int fq) const {
        const int row0 = u.pm * BM + wr * 64 + fr, col0 = u.pn * BM + wc * 32 + 4 * fq;
#pragma unroll
        for (int ai = 0; ai < 2; ++ai)
#pragma unroll
            for (int m = 0; m < 4; ++m) {
                const size_t off = (size_t)(row0 + ai * HALF + m * 16) * DM + col0;
#pragma unroll
                for (int bj = 0; bj < 2; ++bj)
#pragma unroll
                    for (int n = 0; n < 2; ++n) { const u32x2 xw = *(const u32x2*)(x1b + off + bj * HALF + n * 16); f32x4 v = acc[ai][bj][m][n];
                        v[0] += __builtin_bit_cast(float, xw.x << 16); v[1] += __builtin_bit_cast(float, xw.x & 0xffff0000u); v[2] += __builtin_bit_cast(float, xw.y << 16); v[3] += __builtin_bit_cast(float, xw.y & 0xffff0000u);
                        __builtin_nontemporal_store(v, (f32x4*)(out + off + bj * HALF + n * 16)); }
            }
    }
};

template <class Epi, class Sched, bool ALIGN_EPI = false, bool SP2 = false>
__device__ __forceinline__ void gemm_phase(PG8_LAS unsigned char* lds, const Gemm g, const Sched& S, const Epi& E) {
    int tid_ = threadIdx.x; asm volatile("" : "+v"(tid_));
    const int tid = tid_, wid = __builtin_amdgcn_readfirstlane(tid >> 6), lane = tid & 63, wr = wid >> 2, wc = wid & 3, fr = lane & 15, fq = lane >> 4;
    const int K = g.K, nt = K / BK, LD = g.ld;
    unsigned voffA[2], voffB[2];
#pragma unroll
    for (int i = 0; i < 2; ++i) { int R, C; stage_rc(tid * 16 + i * 8192, R, C); const int Rb = Epi::PERM ? ((R & ~31) + perm32(R & 31)) : R;
        voffA[i] = (unsigned)(R * LD + C) * 2u; voffB[i] = (unsigned)(Rb * LD + C) * 2u; }
    const size_t kstep = (size_t)(BK * 2);
    const size_t hstep = (size_t)HALF * LD * 2;
    const size_t tstep = 2 * hstep;
    const unsigned ldsw = (unsigned)wid * 1024u;
    const int aoff = lds_byte(wr * 64 + fr, fq * 8), boff = lds_byte(wc * 32 + fr, fq * 8);
#define PG8_SA(b, h) (((b) * 2 + (h)) * HTB)
#define PG8_SB(b, h) ((4 + (b) * 2 + (h)) * HTB)
#define PG8_STAGE(bufoff, gbase, voff) do { _Pragma("unroll") for (int _i = 0; _i < 2; ++_i) \
        __builtin_amdgcn_global_load_lds((const unsigned*)((const char*)(gbase) + (voff)[_i]), (PG8_LAS unsigned*)(lds + (bufoff) + ldsw + _i * 8192), 16, 0, 0); } while (0)
#define PG8_LDA(dst, b, h) do { _Pragma("unroll") for (int m = 0; m < 4; ++m) _Pragma("unroll") for (int k = 0; k < 2; ++k) dst[m][k] = *(const PG8_LAS bf16x8*)(lds + PG8_SA(b, h) + aoff + m * 2048 + k * 1024); } while (0)
#define PG8_LDB(dst, b, h) do { _Pragma("unroll") for (int n = 0; n < 2; ++n) _Pragma("unroll") for (int k = 0; k < 2; ++k) dst[n][k] = *(const PG8_LAS bf16x8*)(lds + PG8_SB(b, h) + boff + n * 2048 + k * 1024); } while (0)
#define PG8_MMA(ai, bj, At, Bt) do { __builtin_amdgcn_s_setprio(1); _Pragma("unroll") for (int m = 0; m < 4; ++m) _Pragma("unroll") for (int n = 0; n < 2; ++n) _Pragma("unroll") for (int k = 0; k < 2; ++k) \
        acc[ai][bj][m][n] = __builtin_amdgcn_mfma_f32_16x16x32_bf16(Bt[n][k], At[m][k], acc[ai][bj][m][n], 0, 0, 0); __builtin_amdgcn_s_setprio(0); } while (0)
#define PG8_WAIT_V(n) asm volatile("s_waitcnt vmcnt(" #n ")" ::: "memory")
#define PG8_WAIT_L(n) asm volatile("s_waitcnt lgkmcnt(" #n ")" ::: "memory")
#define PG8_BAR __builtin_amdgcn_s_barrier()
#define PG8_SCHED __builtin_amdgcn_sched_barrier(0)
    Unit cur, nxt; int ui = 0;
    if (!S.next(0, cur)) return;
    f32x4 acc[2][2][4][2];
#pragma unroll
    for (int a = 0; a < 2; ++a)
#pragma unroll
        for (int b = 0; b < 2; ++b)
#pragma unroll
            for (int m = 0; m < 4; ++m)
#pragma unroll
                for (int n = 0; n < 2; ++n) acc[a][b][m][n] = (f32x4){0.f, 0.f, 0.f, 0.f};
    bf16x8 At[4][2], B0[2][2], B1[2][2];
    const size_t khstep = (size_t)K * 2;
    const char* cA = (const char*)g.A + (size_t)cur.pm * tstep + cur.kh * khstep; const char* cB = (const char*)g.Bt + (size_t)cur.pn * tstep + cur.kh * khstep;
    S.a_ready(cur);
    if constexpr (SP2) {
        PG8_STAGE(PG8_SB(0, 0), cB, voffB); PG8_STAGE(PG8_SB(0, 1), cB + hstep, voffB); PG8_STAGE(PG8_SA(0, 0), cA, voffA); PG8_STAGE(PG8_SA(0, 1), cA + hstep, voffA);
        if (wr == 1) PG8_BAR;
        PG8_WAIT_V(2); PG8_BAR;
        PG8_STAGE(PG8_SB(1, 0), cB + kstep, voffB); PG8_STAGE(PG8_SA(1, 0), cA + kstep, voffA); PG8_STAGE(PG8_SB(1, 1), cB + hstep + kstep, voffB);
        PG8_WAIT_V(6); PG8_BAR;
    } else {
        PG8_STAGE(PG8_SB(0, 0), cB, voffB); PG8_STAGE(PG8_SA(0, 0), cA, voffA); PG8_STAGE(PG8_SB(0, 1), cB + hstep, voffB); PG8_STAGE(PG8_SA(0, 1), cA + hstep, voffA);
        if (wr == 1) PG8_BAR;
        PG8_WAIT_V(4); PG8_BAR;
        PG8_STAGE(PG8_SB(1, 0), cB + kstep, voffB); PG8_STAGE(PG8_SA(1, 0), cA + kstep, voffA); PG8_STAGE(PG8_SB(1, 1), cB + hstep + kstep, voffB);
        PG8_WAIT_V(6); PG8_BAR;
    }
    for (;;) {
        const bool has_next = S.next(ui + 1, nxt);
        const char* nA = has_next ? (const char*)g.A + (size_t)nxt.pm * tstep + nxt.kh * khstep : cA; const char* nB = has_next ? (const char*)g.Bt + (size_t)nxt.pn * tstep + nxt.kh * khstep : cB;
        for (int t = 0; t < nt; t += 2) {
            const bool last = (t == nt - 2);
            const char* a1 = cA + (size_t)(t + 1) * kstep;
            const char* a2 = last ? nA : cA + (size_t)(t + 2) * kstep; const char* b2 = last ? nB : cB + (size_t)(t + 2) * kstep;
            const char* a3 = a2 + kstep; const char* b3 = b2 + kstep;
            if (last && has_next) S.a_ready(nxt);
            if constexpr (Epi::MIDLOOP) { if (t == (nt >> 1)) E.midloop(acc, cur, wr, fr); }
            if constexpr (SP2) {
            PG8_LDB(B0, 0, 0); PG8_LDB(B1, 0, 1); PG8_SCHED; PG8_LDA(At, 0, 0); PG8_STAGE(PG8_SA(1, 1), a1 + hstep, voffA);
            PG8_WAIT_V(8); PG8_WAIT_L(0); PG8_BAR; PG8_MMA(0, 0, At, B0); PG8_MMA(0, 1, At, B1); PG8_BAR; PG8_SCHED;
            PG8_LDA(At, 0, 1); PG8_STAGE(PG8_SB(0, 0), b2, voffB); PG8_STAGE(PG8_SB(0, 1), b2 + hstep, voffB); PG8_STAGE(PG8_SA(0, 0), a2, voffA);
            PG8_WAIT_V(8); PG8_WAIT_L(0); PG8_BAR; PG8_MMA(1, 0, At, B0); PG8_MMA(1, 1, At, B1); PG8_BAR; PG8_SCHED;
            PG8_LDB(B0, 1, 0); PG8_LDB(B1, 1, 1); PG8_SCHED; PG8_LDA(At, 1, 0); PG8_STAGE(PG8_SA(0, 1), a2 + hstep, voffA);
            PG8_WAIT_V(8); PG8_WAIT_L(0); PG8_BAR; PG8_MMA(0, 0, At, B0); PG8_MMA(0, 1, At, B1); PG8_BAR; PG8_SCHED;
            PG8_LDA(At, 1, 1); PG8_STAGE(PG8_SB(1, 0), b3, voffB); PG8_STAGE(PG8_SB(1, 1), b3 + hstep, voffB); PG8_STAGE(PG8_SA(1, 0), a3, voffA);
            PG8_WAIT_V(8); PG8_WAIT_L(0); PG8_BAR; PG8_MMA(1, 0, At, B0); PG8_MMA(1, 1, At, B1); PG8_BAR; PG8_SCHED;
            } else {
            PG8_LDB(B0, 0, 0); PG8_SCHED; PG8_LDA(At, 0, 0); PG8_STAGE(PG8_SA(1, 1), a1 + hstep, voffA);
            PG8_WAIT_L(8); PG8_BAR; PG8_WAIT_L(0); PG8_MMA(0, 0, At, B0); PG8_BAR; PG8_SCHED;
            PG8_LDB(B1, 0, 1); PG8_STAGE(PG8_SB(0, 0), b2, voffB);
            PG8_BAR; PG8_WAIT_L(0); PG8_MMA(0, 1, At, B1); PG8_BAR;
            PG8_LDA(At, 0, 1); PG8_STAGE(PG8_SA(0, 0), a2, voffA);
            PG8_BAR; PG8_WAIT_L(0); PG8_MMA(1, 0, At, B0); PG8_BAR; PG8_SCHED;
            PG8_STAGE(PG8_SB(0, 1), b2 + hstep, voffB);
            PG8_WAIT_V(6); PG8_BAR; PG8_MMA(1, 1, At, B1); PG8_BAR;
            PG8_LDB(B0, 1, 0); PG8_SCHED; PG8_LDA(At, 1, 0); PG8_STAGE(PG8_SA(0, 1), a2 + hstep, voffA);
            PG8_WAIT_L(8); PG8_BAR; PG8_WAIT_L(0); PG8_MMA(0, 0, At, B0); PG8_BAR; PG8_SCHED;
            PG8_LDB(B1, 1, 1); PG8_STAGE(PG8_SB(1, 0), b3, voffB);
            PG8_BAR; PG8_WAIT_L(0); PG8_MMA(0, 1, At, B1); PG8_BAR;
            PG8_LDA(At, 1, 1); PG8_STAGE(PG8_SA(1, 0), a3, voffA);
            PG8_BAR; PG8_WAIT_L(0); PG8_MMA(1, 0, At, B0); PG8_BAR; PG8_SCHED;
            PG8_STAGE(PG8_SB(1, 1), b3 + hstep, voffB);
            PG8_WAIT_V(6); PG8_BAR; PG8_MMA(1, 1, At, B1); PG8_BAR;
            }
        }
        if constexpr (ALIGN_EPI) { if (wr == 0) PG8_BAR; }
        bool keep = false;
        if constexpr (Epi::MID) { if (cur.kh == 0) { E.mid(acc, cur, wr, wc, fr, fq); keep = true; } else E(acc, cur, wr, wc, fr, fq); }
        else if constexpr (!Epi::AFTER_DRAIN) { E(acc, cur, wr, wc, fr, fq); S.done(cur); }
        if (!has_next) break;
        if (!keep) {
#pragma unroll
        for (int a = 0; a < 2; ++a)
#pragma unroll
            for (int b = 0; b < 2; ++b)
#pragma unroll
                for (int m = 0; m < 4; ++m)
#pragma unroll
                    for (int n = 0; n < 2; ++n) acc[a][b][m][n] = (f32x4){0.f, 0.f, 0.f, 0.f};
        }
        cur = nxt; cA = nA; cB = nB; ++ui;
        if constexpr (ALIGN_EPI) { if (wr == 1) PG8_BAR; }
    }
    PG8_WAIT_V(0);
    if constexpr (!ALIGN_EPI) { if (wr == 0) PG8_BAR; }
    PG8_BAR;
    if constexpr (Epi::AFTER_DRAIN) { E.fused(acc, cur, wr, wc, fr, fq, lds, wid, lane); S.done(cur); }
#undef PG8_SA
#undef PG8_SB
#undef PG8_STAGE
#undef PG8_LDA
#undef PG8_LDB
#undef PG8_MMA
#undef PG8_WAIT_V
#undef PG8_WAIT_L
#undef PG8_BAR
#undef PG8_SCHED
}
}

#define LAS __attribute__((address_space(3)))
typedef unsigned short bf16;
typedef float f32x4 __attribute__((ext_vector_type(4)));
typedef short bf16x8 __attribute__((ext_vector_type(8)));
typedef short s16x4 __attribute__((ext_vector_type(4)));
typedef unsigned v4u __attribute__((ext_vector_type(4)));
typedef unsigned v2u __attribute__((ext_vector_type(2)));
typedef float f32x2 __attribute__((ext_vector_type(2)));
constexpr int NW = 8, NT = 512;
constexpr int T = 16384, D = 2048, INW = 3584, FF = 8192, TH = 8192;
constexpr int LDS_BYTES = 147456, LDS_BARST = LDS_BYTES - 64;
constexpr size_t MiB = 1u << 20;
constexpr size_t WS_BAR = 2 * MiB + 65536  , WS_PAR = 2 * MiB, WS_LNSTAT = 0, WS_SS2 = 131072, WS_R1 = 196608, WS_SSMIX = 262144, WS_TAB = 1310720, WS_WSP = 1835008;
constexpr size_t WS_WIN = 3 * MiB, WS_WOUT = 17 * MiB, WS_WUP = 25 * MiB, WS_WDOWN = 57 * MiB, WS_XB = 89 * MiB, WS_HID = 153 * MiB, WS_MIX = 153 * MiB, WS_END = 281 * MiB;
constexpr int PAR_GQ = 0, PAR_GK = 128, PAR_SINK = 256, PAR_GV = 512, PAR_BV = 1536, PAR_BSP = 2560, PAR_N = 3584;
constexpr int C_Q = 0, C_K = 1024, C_V = 1280, C_U = 1536, C_VG = 2560;
constexpr int QK_STRIDE = 272, V_STRIDE = 288;
constexpr int LQ = 0, LK = 2 * 128 * QK_STRIDE, LV = LK + 128 * QK_STRIDE;
static_assert(LV + 128 * V_STRIDE <= LDS_BYTES, "attention LDS");
constexpr float LOG2E = 1.4426950408889634f;

__device__ __forceinline__ unsigned f2bf(float f) { unsigned u = __builtin_bit_cast(unsigned, f); return (u + 0x7fffu + ((u >> 16) & 1u)) >> 16; }
__device__ __forceinline__ unsigned pk2(float lo, float hi) { return pg8::cvt_pk_bf16(lo, hi); }
__device__ __forceinline__ float bflo(unsigned w) { return __builtin_bit_cast(float, w << 16); }
__device__ __forceinline__ float bfhi(unsigned w) { return __builtin_bit_cast(float, w & 0xffff0000u); }
__device__ __forceinline__ float wave_sum(float v) {
#pragma unroll
    for (int o = 1; o < 64; o <<= 1) v += __shfl_xor(v, o);
    return v;
}
#define LDS_WAIT() asm volatile("s_waitcnt lgkmcnt(0)" ::: "memory")

#define RLX_AGENT __ATOMIC_RELAXED, __HIP_MEMORY_SCOPE_AGENT
#define XB_TMO      128
#define XB_XCNT(j)  (256  + 64 * (j))
#define XB_XSUB(j)  (1280 + 64 * (j))
#define XB_XGEN(j)  (2304 + 64 * (j))
#define XB_TOP      3328
#define XB_TOPGEN   3392
#define XCD_BAR_WORDS 3456
#define XB_SPIN_CAP (1u << 18)

__device__ __forceinline__ unsigned xb_ld(unsigned* p)              { return __hip_atomic_load(p, __ATOMIC_RELAXED, __HIP_MEMORY_SCOPE_AGENT); }
__device__ __forceinline__ unsigned xb_add(unsigned* p, unsigned v) { return __hip_atomic_fetch_add(p, v, __ATOMIC_RELAXED, __HIP_MEMORY_SCOPE_AGENT); }
__device__ __forceinline__ unsigned xb_xcc_id() { return (unsigned)__builtin_amdgcn_s_getreg((3 << 11) | 20) & 0xFu; }
#define XB_SPIN(cond, bar) do { unsigned _sp = 0; while (cond) { __builtin_amdgcn_s_sleep(1); \
    if ((++_sp & 255u) == 0u) { if (xb_ld(&(bar)[XB_TMO])) break; if (_sp > XB_SPIN_CAP) { atomicAdd(&(bar)[XB_TMO], 1u); break; } } } } while (0)

struct XcdBarrier {
    unsigned* bar; unsigned x;
    volatile LAS unsigned* st;
};

__device__ __forceinline__ XcdBarrier xcd_barrier_post(unsigned* bar, volatile LAS unsigned* st) {
    XcdBarrier b; b.bar = bar; b.x = xb_xcc_id(); b.st = st;
    if (threadIdx.x == 0) (void)xb_add(&bar[XB_XCNT(b.x)], 1u);
    return b;
}
__device__ __forceinline__ void xcd_barrier_complete(unsigned* bar, unsigned x, unsigned& nloc, unsigned& nx) {
    const unsigned G = gridDim.x * gridDim.y * gridDim.z;
    unsigned sum, cnt, mine, sp = 0u;
    for (;;) {
        sum = 0u; cnt = 0u; mine = 0u;
#pragma unroll
        for (unsigned j = 0; j < 16; ++j) { const unsigned c = xb_ld(&bar[XB_XCNT(j)]); sum += c; cnt += (c > 0u) ? 1u : 0u; mine = (j == x) ? c : mine; }
        if (sum == G) break;
        __builtin_amdgcn_s_sleep(1);
        if ((++sp & 255u) == 0u) { if (xb_ld(&bar[XB_TMO])) break; if (sp > XB_SPIN_CAP) { atomicAdd(&bar[XB_TMO], 1u); break; } }
    }
    nloc = mine > 0u ? mine : 1u; nx = cnt > 0u ? cnt : 1u;
}

__device__ __forceinline__ void xcd_barrier(const XcdBarrier& b) {
    asm volatile("s_waitcnt vmcnt(0)" ::: "memory");
    __syncthreads();
    if (threadIdx.x == 0) {
        unsigned* bar = b.bar;
        __builtin_amdgcn_s_waitcnt(0);
        unsigned nloc = b.st[0], nx = b.st[1];
        if (nloc == 0u) { xcd_barrier_complete(bar, b.x, nloc, nx); b.st[0] = nloc; b.st[1] = nx; }
        const unsigned old = xb_add(&bar[XB_XSUB(b.x)], 1u);
        const unsigned gen = old / nloc;
        if (old + 1u == (gen + 1u) * nloc) {
            __builtin_amdgcn_fence(__ATOMIC_RELEASE, "agent");
            asm volatile("s_waitcnt vmcnt(0)" ::: "memory");
            const unsigned og = xb_add(&bar[XB_TOP], 1u);
            const unsigned tg = og / nx;
            if (og + 1u == (tg + 1u) * nx) xb_add(&bar[XB_TOPGEN], 1u);
            else XB_SPIN(xb_ld(&bar[XB_TOPGEN]) == tg, bar);
            __builtin_amdgcn_fence(__ATOMIC_ACQUIRE, "agent");
            xb_add(&bar[XB_XGEN(b.x)], 1u);
            asm volatile("s_waitcnt vmcnt(0)" ::: "memory");
        } else {
            XB_SPIN(xb_ld(&bar[XB_XGEN(b.x)]) == gen, bar);
            __builtin_amdgcn_fence(__ATOMIC_ACQUIRE, "agent");
            asm volatile("s_waitcnt vmcnt(0)" ::: "memory");
        }
    }
    __syncthreads();
}


#define XB_LOC_ARR(j) (XCD_BAR_WORDS + 64 * (j))
#define XB_LOC_GEN(j) (XCD_BAR_WORDS + 1024 + 64 * (j))
#define XCD_BAR_WORDS_ALL (XCD_BAR_WORDS + 2048)
__device__ __forceinline__ void xcd_local_barrier(const XcdBarrier& b) {
    asm volatile("s_waitcnt vmcnt(0)" ::: "memory");
    __syncthreads();
    if (threadIdx.x == 0) {
        unsigned* bar = b.bar;
        __builtin_amdgcn_s_waitcnt(0);
        const unsigned nloc = b.st[0];
        const unsigned old = xb_add(&bar[XB_LOC_ARR(b.x)], 1u), gen = old / nloc;
        if (old + 1u == (gen + 1u) * nloc) xb_add(&bar[XB_LOC_GEN(b.x)], 1u);
        else XB_SPIN(xb_ld(&bar[XB_LOC_GEN(b.x)]) == gen, bar);
        __builtin_amdgcn_fence(__ATOMIC_ACQUIRE, "agent");
        asm volatile("s_waitcnt vmcnt(0)" ::: "memory");
    }
    __syncthreads();
}

struct Args {
    const float *xp, *xs, *g_mix, *w_in, *g_q, *g_k, *sink, *g_v_ln, *b_v_ln, *w_sp, *b_sp, *g_ao, *g_go, *w_out, *g_ffn, *w_up, *w_down;
    float* out; unsigned char* ws;
};

__device__ __forceinline__ void transpose_tile(const float* __restrict__ W, int K, int N, bf16* __restrict__ WT, const float* __restrict__ ga, const float* __restrict__ gb, int gsplit, LAS float* scr, int item, int lane) {
    const int nkb = K / 64, nb = item / nkb, kb = item % nkb, k0 = 64 * kb, n0 = 64 * nb;
    const int c = lane & 15, kq = lane >> 4;
    f32x4 v[16];
#pragma unroll
    for (int i = 0; i < 16; ++i) v[i] = __builtin_nontemporal_load((const f32x4*)(W + (size_t)(k0 + 4 * i + kq) * N + n0 + 4 * c));
#pragma unroll
    for (int i = 0; i < 16; ++i) {
        const int k = k0 + 4 * i + kq; float g = 1.0f; if (ga) g = (k < gsplit) ? ga[k] : gb[k - gsplit];
        LAS float* p = scr + (4 * i + kq) * 65 + 4 * c; p[0] = v[i][0] * g; p[1] = v[i][1] * g; p[2] = v[i][2] * g; p[3] = v[i][3] * g;
    }
    LDS_WAIT(); asm volatile("" ::: "memory");
    const int kc = lane & 7;
#pragma unroll
    for (int j = 0; j < 8; ++j) { const int n = (lane >> 3) + 8 * j; const LAS float* sp = scr + (8 * kc) * 65 + n;
        v4u o; o.x = pk2(sp[0 * 65], sp[1 * 65]); o.y = pk2(sp[2 * 65], sp[3 * 65]); o.z = pk2(sp[4 * 65], sp[5 * 65]); o.w = pk2(sp[6 * 65], sp[7 * 65]);
        *(v4u*)(WT + (size_t)(n0 + n) * K + k0 + 8 * kc) = o; }
    LDS_WAIT(); asm volatile("" ::: "memory");
}

__device__ __forceinline__ bf16x8 tr_frag(const LAS unsigned char* p0, const LAS unsigned char* p1) {
    const s16x4 a = __builtin_amdgcn_ds_read_tr16_b64_v4i16((LAS s16x4*)p0);
    const s16x4 b = __builtin_amdgcn_ds_read_tr16_b64_v4i16((LAS s16x4*)p1);
    return __builtin_shufflevector(a, b, 0, 1, 2, 3, 4, 5, 6, 7);
}
__device__ __forceinline__ void tile_ld(v4u (&raw)[4], const bf16* proj, int tok0, int colbase, int tid) {
    const int c = tid & 15, r0 = tid >> 4;
#pragma unroll
    for (int p = 0; p < 4; ++p) raw[p] = *(const v4u*)(proj + (size_t)(tok0 + r0 + 32 * p) * INW + colbase + 8 * c);
}
template <int STRIDE> __device__ __forceinline__ void tile_st(const v4u (&raw)[4], LAS unsigned char* dst, int tid) {
    const int c = tid & 15, r0 = tid >> 4;
#pragma unroll
    for (int p = 0; p < 4; ++p) *(LAS v4u*)(dst + (r0 + 32 * p) * STRIDE + c * 16) = raw[p];
}

__device__ __forceinline__ void attn_unit(const bf16* proj, unsigned char* ws, LAS unsigned char* lds, int a) {
    int tid = threadIdx.x; asm volatile("" : "+v"(tid)); const int lane = tid & 63, wave = __builtin_amdgcn_readfirstlane(tid >> 6);
    const float* par = (const float*)(ws + WS_PAR);
    bf16* mix = (bf16*)(ws + WS_MIX); float* ssmix = (float*)(ws + WS_SSMIX);
    const int gb = a >> 2, kvh = (a >> 1) & 1, hp = a & 1;
    int n, nb; if (gb < 64) { nb = 32; n = gb & 31; } else { nb = 16; n = (gb - 64) & 15; }
    const int tok0 = gb * 128, hw = wave >> 2, rq = wave & 3, fr = lane & 15, fq = lane >> 4;
    const int h0 = kvh * 4 + hp * 2, h = h0 + hw;
    LAS unsigned char* QS = lds + LQ; LAS unsigned char* KS = lds + LK; LAS unsigned char* VS = lds + LV;
    const int kb0 = (n > 0) ? n - 1 : 0, kb1 = (n + 1 < nb) ? n + 1 : nb - 1;
    v4u kr[4], vr[4];
    {
        v4u q0[4], q1[4];
        tile_ld(q0, proj, tok0, C_Q + h0 * 128, tid); tile_ld(q1, proj, tok0, C_Q + (h0 + 1) * 128, tid);
        tile_ld(kr, proj, tok0 + (kb0 - n) * 128, C_K + kvh * 128, tid); tile_ld(vr, proj, tok0 + (kb0 - n) * 128, C_V + kvh * 128, tid);
        __syncthreads();
        tile_st<QK_STRIDE>(q0, QS, tid); tile_st<QK_STRIDE>(q1, QS + 128 * QK_STRIDE, tid);
    }
    const LAS unsigned char* qbase = QS + hw * (128 * QK_STRIDE) + (rq * 32 + fr) * QK_STRIDE + (8 * fq) * 2;
    const float sk2 = par[PAR_SINK + h] * LOG2E;
    float mrow[2], lrow[2]; mrow[0] = mrow[1] = sk2; lrow[0] = lrow[1] = (fq == 0) ? 1.0f : 0.0f;
    f32x4 O[2][8];
#pragma unroll
    for (int rt = 0; rt < 2; ++rt)
#pragma unroll
        for (int dt = 0; dt < 8; ++dt) O[rt][dt] = (f32x4){0.f, 0.f, 0.f, 0.f};
#pragma unroll 1
    for (int kb = kb0; kb <= kb1; ++kb) {
        if (kb != kb0) __syncthreads();
        tile_st<QK_STRIDE>(kr, KS, tid); tile_st<V_STRIDE>(vr, VS, tid);
        __syncthreads();
        if (kb < kb1) { tile_ld(kr, proj, tok0 + (kb + 1 - n) * 128, C_K + kvh * 128, tid); tile_ld(vr, proj, tok0 + (kb + 1 - n) * 128, C_V + kvh * 128, tid); }
        f32x4 st[2][8];
#pragma unroll
        for (int kt = 0; kt < 8; ++kt) { st[0][kt] = (f32x4){0.f, 0.f, 0.f, 0.f}; st[1][kt] = (f32x4){0.f, 0.f, 0.f, 0.f}; }
#pragma unroll
        for (int s = 0; s < 4; ++s) {
            const bf16x8 qa = *(const LAS bf16x8*)(qbase + 64 * s), qb = *(const LAS bf16x8*)(qbase + 16 * QK_STRIDE + 64 * s);
#pragma unroll
            for (int kt = 0; kt < 8; ++kt) {
                const bf16x8 kf = *(const LAS bf16x8*)(KS + (16 * kt + fr) * QK_STRIDE + (32 * s + 8 * fq) * 2);
                st[0][kt] = __builtin_amdgcn_mfma_f32_16x16x32_bf16(kf, qa, st[0][kt], 0, 0, 0);
                st[1][kt] = __builtin_amdgcn_mfma_f32_16x16x32_bf16(kf, qb, st[1][kt], 0, 0, 0);
            }
        }
        bf16x8 pb[2][4];
#pragma unroll
        for (int rt = 0; rt < 2; ++rt) {
            const int qi = rq * 32 + rt * 16 + fr;
            if (kb != n) {
                const int sgn = (kb < n) ? 1 : -1, dbase = sgn * (4 * fq - qi);
#pragma unroll
                for (int kt = 0; kt < 8; ++kt)
#pragma unroll
                    for (int r = 0; r < 4; ++r) { const int dd = dbase + sgn * (16 * kt + r); st[rt][kt][r] += __builtin_bit_cast(float, (unsigned)(dd >> 31) & 0xF149F2CAu); }
            }
            float mx = -1e30f;
#pragma unroll
            for (int kt = 0; kt < 8; ++kt)
#pragma unroll
                for (int r = 0; r < 4; ++r) mx = fmaxf(mx, st[rt][kt][r]);
            mx = fmaxf(mx, __shfl_xor(mx, 16)); mx = fmaxf(mx, __shfl_xor(mx, 32));
            const float mnew = fmaxf(mrow[rt], mx), alpha = __builtin_amdgcn_exp2f(mrow[rt] - mnew);
            mrow[rt] = mnew; float ls = lrow[rt] * alpha;
#pragma unroll
            for (int dt = 0; dt < 8; ++dt) O[rt][dt] *= alpha;
#pragma unroll
            for (int kt = 0; kt < 8; ++kt)
#pragma unroll
                for (int r = 0; r < 4; ++r) { const float p = __builtin_amdgcn_exp2f(st[rt][kt][r] - mnew); st[rt][kt][r] = p; ls += p; }
            lrow[rt] = ls;
#pragma unroll
            for (int tp = 0; tp < 4; ++tp) {
                v4u w; w.x = pk2(st[rt][2 * tp][0], st[rt][2 * tp][1]); w.y = pk2(st[rt][2 * tp][2], st[rt][2 * tp][3]);
                w.z = pk2(st[rt][2 * tp + 1][0], st[rt][2 * tp + 1][1]); w.w = pk2(st[rt][2 * tp + 1][2], st[rt][2 * tp + 1][3]);
                pb[rt][tp] = __builtin_bit_cast(bf16x8, w);
            }
        }
#pragma unroll
        for (int dt = 0; dt < 8; ++dt)
#pragma unroll
            for (int tp = 0; tp < 4; ++tp) {
                const LAS unsigned char* p0 = VS + (32 * tp + 4 * fq + (fr >> 2)) * V_STRIDE + (16 * dt + 4 * (fr & 3)) * 2;
                const bf16x8 vf = tr_frag(p0, p0 + 16 * V_STRIDE);
                O[0][dt] = __builtin_amdgcn_mfma_f32_16x16x32_bf16(vf, pb[0][tp], O[0][dt], 0, 0, 0);
                O[1][dt] = __builtin_amdgcn_mfma_f32_16x16x32_bf16(vf, pb[1][tp], O[1][dt], 0, 0, 0);
            }
    }
#pragma unroll
    for (int rt = 0; rt < 2; ++rt) {
        float lt = lrow[rt]; lt += __shfl_xor(lt, 16); lt += __shfl_xor(lt, 32);
        const float inv = 1.0f / lt; const int tok = tok0 + rq * 32 + rt * 16 + fr; float ss = 0.f;
        bf16* orow = mix + (size_t)tok * D + h * 128 + 4 * fq;
#pragma unroll
        for (int dt = 0; dt < 8; ++dt) { const f32x4 o = O[rt][dt] * inv; ss += (o[0] * o[0] + o[1] * o[1]) + (o[2] * o[2] + o[3] * o[3]);
            v2u w; w.x = pk2(o[0], o[1]); w.y = pk2(o[2], o[3]); *(v2u*)(orow + 16 * dt) = w; }
        ss += __shfl_xor(ss, 16); ss += __shfl_xor(ss, 32);
        if (fq == 0) unsafeAtomicAdd(ssmix + (size_t)tok * 2, ss);
    }
}

__device__ __forceinline__ void gmlp_unit(const bf16* proj, unsigned char* ws, LAS unsigned char* lds, int gu) {
    int tid = threadIdx.x; asm volatile("" : "+v"(tid)); const int lane = tid & 63, wave = __builtin_amdgcn_readfirstlane(tid >> 6);
    const float* par = (const float*)(ws + WS_PAR);
    const float* lnstat = (const float*)(ws + WS_LNSTAT); const bf16* wsp = (const bf16*)(ws + WS_WSP);
    bf16* mix = (bf16*)(ws + WS_MIX); float* ssmix = (float*)(ws + WS_SSMIX);
    const int gb = gu >> 3, h = gu & 7, tok0 = gb * 128, fr = lane & 15, fq = lane >> 4;
    LAS unsigned char* VN = lds;
    const int c = tid & 15, r0 = tid >> 4;
    v4u raw[4]; f32x2 stv[4];
    tile_ld(raw, proj, tok0, C_VG + h * 128, tid);
#pragma unroll
    for (int p = 0; p < 4; ++p) stv[p] = *(const f32x2*)(lnstat + 2 * (tok0 + r0 + 32 * p));
    const f32x4 g0 = *(const f32x4*)(par + PAR_GV + h * 128 + 8 * c), g1 = *(const f32x4*)(par + PAR_GV + h * 128 + 8 * c + 4);
    const f32x4 b0 = *(const f32x4*)(par + PAR_BV + h * 128 + 8 * c), b1 = *(const f32x4*)(par + PAR_BV + h * 128 + 8 * c + 4);
    bf16x8 wf[4];
#pragma unroll
    for (int s = 0; s < 4; ++s) wf[s] = *(const bf16x8*)(wsp + ((size_t)(h * 128 + 16 * wave + fr) * 128 + 32 * s + 8 * fq));
    const int tok = tok0 + 16 * wave + fr; const float bsp = par[PAR_BSP + h * 128 + 16 * wave + fr];
    const bf16* urow = proj + (size_t)tok * INW + C_U + h * 128 + 4 * fq; bf16* orow = mix + (size_t)tok * D + 1024 + h * 128 + 4 * fq;
    v2u uw[8];
#pragma unroll
    for (int ct = 0; ct < 8; ++ct) uw[ct] = *(const v2u*)(urow + 16 * ct);
    __syncthreads();
#pragma unroll
    for (int p = 0; p < 4; ++p) {
        const float mu = stv[p][0] * (1.0f / 1024.0f), var = fmaxf(stv[p][1] * (1.0f / 1024.0f) - mu * mu, 0.f), rstd = 1.0f / sqrtf(var + pg8::EPSN);
        float v[8];
        v[0] = bflo(raw[p].x); v[1] = bfhi(raw[p].x); v[2] = bflo(raw[p].y); v[3] = bfhi(raw[p].y); v[4] = bflo(raw[p].z); v[5] = bfhi(raw[p].z); v[6] = bflo(raw[p].w); v[7] = bfhi(raw[p].w);
#pragma unroll
        for (int e = 0; e < 4; ++e) { v[e] = (v[e] - mu) * rstd * g0[e] + b0[e]; v[4 + e] = (v[4 + e] - mu) * rstd * g1[e] + b1[e]; }
        v4u o; o.x = pk2(v[0], v[1]); o.y = pk2(v[2], v[3]); o.z = pk2(v[4], v[5]); o.w = pk2(v[6], v[7]);
        *(LAS v4u*)(VN + (r0 + 32 * p) * V_STRIDE + c * 16) = o;
    }
    __syncthreads();
    f32x4 acc[8];
#pragma unroll
    for (int ct = 0; ct < 8; ++ct) {
        acc[ct] = (f32x4){0.f, 0.f, 0.f, 0.f};
#pragma unroll
        for (int s = 0; s < 4; ++s) {
            const LAS unsigned char* p0 = VN + (32 * s + 8 * fq + (fr >> 2)) * V_STRIDE + (16 * ct + 4 * (fr & 3)) * 2;
            const bf16x8 vf = tr_frag(p0, p0 + 4 * V_STRIDE);
            acc[ct] = __builtin_amdgcn_mfma_f32_16x16x32_bf16(vf, wf[s], acc[ct], 0, 0, 0);
        }
    }
    float ss = 0.f;
#pragma unroll
    for (int ct = 0; ct < 8; ++ct) {
        const float o0 = bflo(uw[ct].x) * (acc[ct][0] + bsp), o1 = bfhi(uw[ct].x) * (acc[ct][1] + bsp), o2 = bflo(uw[ct].y) * (acc[ct][2] + bsp), o3 = bfhi(uw[ct].y) * (acc[ct][3] + bsp);
        ss += (o0 * o0 + o1 * o1) + (o2 * o2 + o3 * o3);
        v2u w; w.x = pk2(o0, o1); w.y = pk2(o2, o3); *(v2u*)(orow + 16 * ct) = w;
    }
    ss += __shfl_xor(ss, 16); ss += __shfl_xor(ss, 32);
    if (fq == 0) unsafeAtomicAdd(ssmix + (size_t)tok * 2 + 1, ss);
}

__device__ __forceinline__ void convert_out_down(const Args& A, LAS unsigned char* lds, int vcu, int G) {
    int tid = threadIdx.x; asm volatile("" : "+v"(tid)); const int lane = tid & 63, wave = __builtin_amdgcn_readfirstlane(tid >> 6);
    unsigned char* ws = A.ws;
    __syncthreads();
    LAS float* scr = (LAS float*)(lds + wave * 16640);
    constexpr int I_OUT0 = (D / 64) * (D / 64), I_DN0 = (FF / 64) * (D / 64);
    for (int it = vcu * NW + wave; it < I_OUT0 + I_DN0; it += G * NW) {
        if (it < I_OUT0) transpose_tile(A.w_out, D, D, (bf16*)(ws + WS_WOUT), A.g_ao, A.g_go, 1024, scr, it, lane);
        else transpose_tile(A.w_down, FF, D, (bf16*)(ws + WS_WDOWN), nullptr, nullptr, 0, scr, it - I_OUT0, lane);
    }
    __syncthreads();
}

template <int HF> __device__ __forceinline__ void ffn_half(const Args& A, LAS unsigned char* lds, int G, int bx, const XcdBarrier& xb, bool hwx) {
    unsigned char* ws = A.ws;
    bf16* HID = (bf16*)(ws + WS_HID);
    {
        pg8::Gemm g{(const bf16*)(ws + WS_XB) + (size_t)HF * TH * D, (const bf16*)(ws + WS_WUP), TH, FF, D, D}; pg8::StaticOrder S; S.init(TH, FF, G, bx, 4);
        pg8::EpiUp E{HID, (const float*)(ws + WS_SS2) + HF * TH};
        pg8::gemm_phase<pg8::EpiUp, pg8::StaticOrder, true, true>(lds, g, S, E);
    }
    if (hwx) xcd_local_barrier(xb); else xcd_barrier(xb);
    {
        pg8::Gemm g{HID, (const bf16*)(ws + WS_WDOWN), TH, D, FF, FF}; pg8::StaticOrder S; S.init(TH, D, G, bx, 4);
        pg8::EpiDown E{A.out + (size_t)HF * TH * D, (const bf16*)(ws + WS_XB) + (size_t)HF * TH * D};
        pg8::gemm_phase<pg8::EpiDown, pg8::StaticOrder, true, true>(lds, g, S, E);
    }
}

__global__ void __launch_bounds__(NT, 2) fwd_mega(Args A) {
    extern __shared__ __attribute__((aligned(16))) unsigned char lds_raw[];
    LAS unsigned char* lds = (LAS unsigned char*)lds_raw;
    cg::grid_group grid = cg::this_grid();
    const int tid = threadIdx.x, lane = tid & 63, wave = __builtin_amdgcn_readfirstlane(tid >> 6);
    const int G = gridDim.x, bx = blockIdx.x;
    const int vcu = (G % 8 == 0) ? (bx % 8) * (G / 8) + bx / 8 : bx;
    unsigned char* ws = A.ws;
    bf16* WinT = (bf16*)(ws + WS_WIN); bf16* WoutT = (bf16*)(ws + WS_WOUT); bf16* WupT = (bf16*)(ws + WS_WUP); bf16* WdownT = (bf16*)(ws + WS_WDOWN);
    bf16* XB = (bf16*)(ws + WS_XB); bf16* HID = (bf16*)(ws + WS_HID); bf16* MIX = (bf16*)(ws + WS_MIX);
    float* lnstat = (float*)(ws + WS_LNSTAT); float* ss2 = (float*)(ws + WS_SS2); float* r1 = (float*)(ws + WS_R1); float* ssmix = (float*)(ws + WS_SSMIX);
    bf16* PROJ = (bf16*)A.out;
    if (tid < 2) ((LAS unsigned*)(lds + LDS_BARST))[tid] = 0u;
    unsigned* barw = (unsigned*)(ws + WS_BAR);
    if (bx == 0) for (int i = tid; i < XCD_BAR_WORDS_ALL; i += NT) barw[i] = 0u;
    grid.sync();
    XcdBarrier xbar; xbar.bar = barw; xbar.x = xb_xcc_id(); xbar.st = (volatile LAS unsigned*)(lds + LDS_BARST);
    if (tid == 0) ((LAS unsigned*)(lds + LDS_BARST))[2] = xb_add(&barw[XB_XCNT(xbar.x)], 1u);

    {
        const int gw = vcu * NW + wave, NGW = G * NW;
        LAS float* scr = (LAS float*)(lds + wave * 16640);
        constexpr int I_IN = (D / 64) * (INW / 64);
        for (int it = gw; it < I_IN; it += NGW) transpose_tile(A.w_in, D, INW, WinT, A.g_mix, A.g_mix, D, scr, it, lane);
        for (int m = gw; m < T; m += NGW) {
            const float* xrow = (m < 8192) ? A.xp + (size_t)m * D : A.xs + (size_t)(m - 8192) * D;
            const f32x4* xr = (const f32x4*)xrow + lane; f32x4 v[8]; float s = 0.f;
#pragma unroll
            for (int j = 0; j < 8; ++j) { v[j] = __builtin_nontemporal_load(xr + 64 * j); s += (v[j][0] * v[j][0] + v[j][1] * v[j][1]) + (v[j][2] * v[j][2] + v[j][3] * v[j][3]); }
            s = wave_sum(s);
            if (lane == 0) r1[m] = 1.0f / sqrtf(s * (1.0f / D) + pg8::EPSN);
            v2u* o8 = (v2u*)(XB + (size_t)m * D) + lane;
#pragma unroll
            for (int j = 0; j < 8; ++j) { v2u w; w.x = pk2(v[j][0], v[j][1]); w.y = pk2(v[j][2], v[j][3]); o8[64 * j] = w; }
        }
        const int gt = vcu * NT + tid, NGT = G * NT;
        for (int i = gt; i < 8 * 128 * 128; i += NGT) ((bf16*)(ws + WS_WSP))[i] = (bf16)f2bf(A.w_sp[i]);
        for (int i = gt; i < 4096 * 16; i += NGT) {
            const int pos = i >> 4, k = i & 15;
            const float inv_freq = __builtin_amdgcn_exp2f(-(float)k * (18.931568569324174f / 16.0f));
            const float ang = (float)pos * inv_freq, rev = ang * 0.15915494309189535f, fr = rev - floorf(rev);
            float* tp = (float*)(ws + WS_TAB) + 2 * (size_t)i; tp[0] = __builtin_amdgcn_cosf(fr); tp[1] = __builtin_amdgcn_sinf(fr);
        }
        for (int i = gt; i < PAR_N; i += NGT) {
            float v = 0.f;
            if (i < PAR_GK) v = A.g_q[i]; else if (i < PAR_SINK) v = A.g_k[i - PAR_GK]; else if (i < PAR_SINK + 8) v = A.sink[i - PAR_SINK];
            else if (i < PAR_GV) v = 0.f; else if (i < PAR_BV) v = A.g_v_ln[i - PAR_GV]; else if (i < PAR_BSP) v = A.b_v_ln[i - PAR_BV]; else v = A.b_sp[i - PAR_BSP];
            ((float*)(ws + WS_PAR))[i] = v;
        }
        for (int i = gt; i < 2 * T; i += NGT) { lnstat[i] = 0.f; ssmix[i] = 0.f; }
        for (int i = gt; i < T; i += NGT) ss2[i] = 0.f;
    }
    xcd_barrier(xbar);
    if (tid == 0) {
        bool ok = (G % 8 == 0);
        for (unsigned j = 0; j < 16; ++j) { const unsigned cj = xb_ld(&barw[XB_XCNT(j)]); ok = ok && ((j < 8) ? (cj == (unsigned)(G / 8)) : (cj == 0u)); }
        LAS unsigned* st = (LAS unsigned*)(lds + LDS_BARST); st[3] = ok ? (st[2] * 8u + xbar.x) : (unsigned)bx; st[4] = ok ? 1u : 0u;
    }
    __syncthreads();
    const int cid = __builtin_amdgcn_readfirstlane((int)((LAS unsigned*)(lds + LDS_BARST))[3]);
    const int vcu2 = (G % 8 == 0) ? (cid % 8) * (G / 8) + cid / 8 : cid;
    const bool hwx = __builtin_amdgcn_readfirstlane((int)((LAS unsigned*)(lds + LDS_BARST))[4]) != 0;
    {
        pg8::Gemm g{XB, WinT, T, INW, D, D}; pg8::StaticOrder S; S.init(T, INW, G, cid, 4);
        pg8::EpiProj E{PROJ, r1, lnstat, (const float*)(ws + WS_PAR) + PAR_GQ, (const float*)(ws + WS_PAR) + PAR_GK, (const float*)(ws + WS_TAB), (LAS float*)(lds + 131072)};
        pg8::gemm_phase<pg8::EpiProj, pg8::StaticOrder, true, true>(lds, g, S, E);
        constexpr int NU = (T / 256) * (INW / 256);
        const int rem = NU % G, NH = (rem == 0) ? G : G - rem, hi = (rem == 0) ? cid : cid - rem;
        if (hi >= 0) {
            constexpr int I_UP = (D / 64) * (FF / 64);
            LAS float* scr = (LAS float*)(lds + wave * 16640);
            for (int it = hi * NW + wave; it < I_UP; it += NH * NW) transpose_tile(A.w_up, D, FF, WupT, A.g_ffn, A.g_ffn, D, scr, it, lane);
        }
    }
    xcd_barrier(xbar);
    if (!(vcu2 & 1)) convert_out_down(A, lds, vcu2, G);
#pragma unroll 1
    for (int u = vcu2; u < 1536; u += G) {
        if (u < 512) attn_unit(PROJ, ws, lds, u);
        else gmlp_unit(PROJ, ws, lds, u - 512);
    }
    if (vcu2 & 1) convert_out_down(A, lds, vcu2, G);
    xcd_barrier(xbar);
    {
        pg8::Gemm g{MIX, WoutT, T, D, D, D}; pg8::StaticOrder S; S.init(T, D, G, cid, 4, true);
        LAS pg8::f32x2* sct = (LAS pg8::f32x2*)(lds + 131072);
        for (int e = tid; e < 7 * 256; e += NT) {
            pg8::Unit u; if (!S.next(e >> 8, u)) break;
            const pg8::f32x2 p = *(const pg8::f32x2*)(ssmix + (size_t)(u.pm * 256 + (e & 255)) * 2);
            const float va = p[0] * (1.0f / 1024.0f) + pg8::EPSN, vg = p[1] * (1.0f / 1024.0f) + pg8::EPSN;
            pg8::f32x2 o; o[1] = __builtin_amdgcn_rsqf(vg); o[0] = __builtin_amdgcn_rsqf(va) * __builtin_amdgcn_sqrtf(vg); sct[e] = o;
        }
        __syncthreads();
        pg8::EpiOut E{XB, ss2, sct};
        pg8::gemm_phase<pg8::EpiOut, pg8::StaticOrder, true, true>(lds, g, S, E);
    }
    if (hwx) xcd_local_barrier(xbar); else xcd_barrier(xbar);
    ffn_half<0>(A, lds, G, cid, xbar, hwx);
    if (hwx) xcd_local_barrier(xbar); else xcd_barrier(xbar);
    ffn_half<1>(A, lds, G, cid, xbar, hwx);
}

extern "C" void kernel_launch(void* const* d_in, const int* in_sizes, int n_in, void* d_out, int out_size, void* d_ws, size_t ws_size, hipStream_t stream) {
    static int grid = 0;
    if (grid == 0) {
        if (n_in != 17 || out_size != T * D || ws_size < WS_END) { fprintf(stderr, "kernel_launch: unexpected sizes n_in %d out %d ws %zu (need %zu)\n", n_in, out_size, ws_size, (size_t)WS_END); }
        int dev = 0, cus = 0, per_cu = 0;
        (void)hipGetDevice(&dev); (void)hipDeviceGetAttribute(&cus, hipDeviceAttributeMultiprocessorCount, dev);
        if (hipFuncSetAttribute((const void*)fwd_mega, hipFuncAttributeMaxDynamicSharedMemorySize, LDS_BYTES) != hipSuccess) fprintf(stderr, "kernel_launch: hipFuncSetAttribute failed\n");
        if (hipOccupancyMaxActiveBlocksPerMultiprocessor(&per_cu, (const void*)fwd_mega, NT, LDS_BYTES) != hipSuccess || per_cu < 1) { fprintf(stderr, "kernel_launch: occupancy query gave %d\n", per_cu); per_cu = 1; }
        (void)hipGetLastError();
        if (cus <= 0) cus = 256;
        grid = cus * per_cu;
        fprintf(stderr, "kernel_launch: grid %d (cus %d per_cu %d) ws %zu\n", grid, cus, per_cu, ws_size);
    }
    Args a{};
    a.xp = (const float*)d_in[0]; a.xs = (const float*)d_in[1]; a.g_mix = (const float*)d_in[2]; a.w_in = (const float*)d_in[3]; a.g_q = (const float*)d_in[4]; a.g_k = (const float*)d_in[5];
    a.sink = (const float*)d_in[6]; a.g_v_ln = (const float*)d_in[7]; a.b_v_ln = (const float*)d_in[8]; a.w_sp = (const float*)d_in[9]; a.b_sp = (const float*)d_in[10];
    a.g_ao = (const float*)d_in[11]; a.g_go = (const float*)d_in[12]; a.w_out = (const float*)d_in[13]; a.g_ffn = (const float*)d_in[14]; a.w_up = (const float*)d_in[15]; a.w_down = (const float*)d_in[16];
    a.out = (float*)d_out; a.ws = (unsigned char*)d_ws;
    void* args[] = {&a};
    hipError_t e = hipLaunchCooperativeKernel((const void*)fwd_mega, dim3(grid), dim3(NT), args, LDS_BYTES, stream);
    if (e != hipSuccess) fprintf(stderr, "kernel_launch: cooperative launch failed: %s (grid %d)\n", hipGetErrorString(e), grid);
}
```

```cpp
#include <hip/hip_runtime.h>
#include <hip/hip_cooperative_groups.h>
#include <cstdio>
#include <cstdint>
namespace cg = cooperative_groups;
namespace pg8 {
#define PG8_LAS __attribute__((address_space(3)))
typedef unsigned short bf16_t;
typedef short bf16x8 __attribute__((ext_vector_type(8)));
typedef float f32x4 __attribute__((ext_vector_type(4)));
typedef unsigned u32x4 __attribute__((ext_vector_type(4)));
constexpr int BM = 256, BK = 64, HALF = 128, HTB = HALF * BK * 2  , STAGE_BYTES = 8 * HTB, NXCD = 8, WGM = 8;

__host__ __device__ __forceinline__ int lds_byte(int r, int c) { const int st = (r >> 4) * 2 + (c >> 5), rr = r & 15, cc = c & 31, ob = rr * 64 + cc * 2; return st * 1024 + (ob ^ (((ob >> 9) & 1) << 5)); }
__host__ __device__ __forceinline__ void stage_rc(int b, int& R, int& C) { const int st = b / 1024, sb = b % 1024, swz = sb ^ (((sb >> 9) & 1) << 5); R = (st >> 1) * 16 + swz / 64; C = (st & 1) * 32 + (swz % 64) / 2; }
__host__ __device__ __forceinline__ int perm32(int rho) { const int n = rho >> 4, i = rho & 15; return 8 * (i >> 2) + 4 * n + (i & 3); }

struct Unit { int pm, pn, kh, slot; };
struct Gemm { const bf16_t* A; const bf16_t* Bt; int M, N, K, ld; };

struct StaticOrder {
    int nM, nN, nwg, G, c, wgm; bool halves;
    __host__ __device__ void init(int M, int N, int G_, int c_, int wgm_ = WGM, bool halves_ = false) { nM = M / BM; nN = N / BM; nwg = nM * nN; G = G_; c = c_; wgm = wgm_; halves = halves_; }
    __host__ __device__ bool next(int i, Unit& u) const {
        const long L = (long)i * G + c; if (L >= nwg) return false;
        int wgid = (int)L; { const int q = nwg / NXCD, r = nwg % NXCD, xcd = wgid % NXCD, off = wgid / NXCD; wgid = (xcd < r ? xcd * (q + 1) : r * (q + 1) + (xcd - r) * q) + off; }
        const int nig = wgm * nN, gid = wgid / nig, fm = gid * wgm, gsz = (nM - fm) < wgm ? (nM - fm) : wgm;
        u.pm = fm + ((wgid % nig) % gsz); u.pn = (wgid % nig) / gsz; if (halves) { const int x = u.pm >> 3, j = u.pm & 7; u.pm = (j >> 2) * 32 + 4 * x + (j & 3); } u.kh = 0; u.slot = i; return true;
    }
    __device__ __forceinline__ void a_ready(const Unit&) const {}
    __device__ __forceinline__ void done(const Unit&) const {}
};
__device__ __forceinline__ unsigned cvt_pk_bf16(float lo, float hi) { unsigned r; asm volatile("v_cvt_pk_bf16_f32 %0, %1, %2" : "=v"(r) : "v"(lo), "v"(hi)); return r; }
struct SplitOrder : StaticOrder {
    __host__ __device__ bool next(int i, Unit& u) const { if (!StaticOrder::next(i >> 1, u)) return false; u.kh = i & 1; u.slot = i >> 1; return true; }
};
typedef float f32x2 __attribute__((ext_vector_type(2)));
typedef unsigned u32x2 __attribute__((ext_vector_type(2)));
__device__ __forceinline__ float gelu_tanh(float x) {
    const float t = x * x * 0.044715f + 1.0f;
    const float e = __builtin_amdgcn_exp2f(x * t * (-2.0f * 0.7978845608028654f * 1.4426950408889634f));
    return x * __builtin_amdgcn_rcpf(1.0f + e);
}
constexpr int PROJ_LD = 3584, DM = 2048, DFF = 8192;
constexpr float EPSN = 1e-6f;

struct EpiProj {
    static constexpr bool PERM = true, AFTER_DRAIN = false, MID = false, MIDLOOP = false;
    bf16_t* O; const float* r1; float* lnstat; const float* gq; const float* gk; const float* tab; PG8_LAS float* xch;
    __device__ __forceinline__ void operator()(const f32x4 (&acc)[2][2][4][2], const Unit& u, int wr, int wc, int fr, int fq) const {
        const int row0 = u.pm * BM + wr * 64 + fr, col0 = u.pn * BM + wc * 32 + 8 * fq;
        if (u.pn <= 4) {
            float rsv[2][4];
#pragma unroll
            for (int ai = 0; ai < 2; ++ai)
#pragma unroll
                for (int m = 0; m < 4; ++m) {
                    const float rs = r1[row0 + ai * HALF + m * 16]; rsv[ai][m] = rs;
#pragma unroll
                    for (int bj = 0; bj < 2; ++bj) {
                        const f32x4 v0 = acc[ai][bj][m][0] * rs, v1 = acc[ai][bj][m][1] * rs;
                        float s = (v0[0] * v0[0] + v0[1] * v0[1]) + (v0[2] * v0[2] + v0[3] * v0[3]) + (v1[0] * v1[0] + v1[1] * v1[1]) + (v1[2] * v1[2] + v1[3] * v1[3]);
                        s += __shfl_xor(s, 16); s += __shfl_xor(s, 32);
                        if (fq == 0) xch[((((wr * 4 + wc) * 2 + ai) * 4 + m) * 2 + bj) * 16 + fr] = s;
                    }
                }
            asm volatile("s_waitcnt lgkmcnt(0)" ::: "memory"); __builtin_amdgcn_s_barrier(); asm volatile("" ::: "memory");
            const bool isq = u.pn < 4; const float* gp = (isq ? gq : gk) + wc * 32 + 8 * fq;
            const f32x4 g0 = *(const f32x4*)gp, g1 = *(const f32x4*)(gp + 4);
            const float osc = isq ? 0.08838834764831845f * 1.4426950408889634f : 1.0f;
#pragma unroll
            for (int ai = 0; ai < 2; ++ai)
#pragma unroll
                for (int m = 0; m < 4; ++m) {
                    const int row = row0 + ai * HALF + m * 16; const float rs = rsv[ai][m];
                    bf16_t* rowp = O + (size_t)row * PROJ_LD + col0;
                    f32x4 c0 = {0.f, 0.f, 0.f, 0.f}, c1 = c0, c2 = c0, c3 = c0;
                    if (wc == 0) { const int pos = (row < 8192) ? (row & 4095) : (row & 2047); const f32x4* tp = (const f32x4*)(tab + ((size_t)pos * 16 + 8 * (fq & 1)) * 2); c0 = tp[0]; c1 = tp[1]; c2 = tp[2]; c3 = tp[3]; }
#pragma unroll
                    for (int bj = 0; bj < 2; ++bj) {
                        float tot = 0.f;
#pragma unroll
                        for (int w = 0; w < 4; ++w) tot += xch[((((wr * 4 + w) * 2 + ai) * 4 + m) * 2 + bj) * 16 + fr];
                        const float sc = rs * __builtin_amdgcn_rsqf(tot * (1.0f / 128.0f) + EPSN);
                        f32x4 v0 = acc[ai][bj][m][0] * sc * g0, v1 = acc[ai][bj][m][1] * sc * g1;
                        if (wc == 0) {
                            f32x4 p0, p1;
#pragma unroll
                            for (int j = 0; j < 4; ++j) { p0[j] = __shfl_xor(v0[j], 32); p1[j] = __shfl_xor(v1[j], 32); }
                            const float sg = (fq < 2) ? -1.0f : 1.0f;
                            v0[0] = v0[0] * c0[0] + sg * p0[0] * c0[1]; v0[1] = v0[1] * c0[2] + sg * p0[1] * c0[3]; v0[2] = v0[2] * c1[0] + sg * p0[2] * c1[1]; v0[3] = v0[3] * c1[2] + sg * p0[3] * c1[3];
                            v1[0] = v1[0] * c2[0] + sg * p1[0] * c2[1]; v1[1] = v1[1] * c2[2] + sg * p1[1] * c2[3]; v1[2] = v1[2] * c3[0] + sg * p1[2] * c3[1]; v1[3] = v1[3] * c3[2] + sg * p1[3] * c3[3];
                        }
                        v0 *= osc; v1 *= osc;
                        u32x4 w; w.x = cvt_pk_bf16(v0[0], v0[1]); w.y = cvt_pk_bf16(v0[2], v0[3]); w.z = cvt_pk_bf16(v1[0], v1[1]); w.w = cvt_pk_bf16(v1[2], v1[3]);
                        __builtin_nontemporal_store(w, (u32x4*)(rowp + bj * HALF));
                    }
                }
            return;
        }
        const bool act = u.pn >= 6, st = u.pn >= 10;
#pragma unroll
        for (int ai = 0; ai < 2; ++ai)
#pragma unroll
            for (int m = 0; m < 4; ++m) {
                const int row = row0 + ai * HALF + m * 16; const float rs = r1[row];
                bf16_t* rowp = O + (size_t)row * PROJ_LD + col0; float s1 = 0.f, s2 = 0.f;
#pragma unroll
                for (int bj = 0; bj < 2; ++bj) {
                    f32x4 v0 = acc[ai][bj][m][0] * rs, v1 = acc[ai][bj][m][1] * rs;
                    if (act) {
#pragma unroll
                        for (int j = 0; j < 4; ++j) { v0[j] = gelu_tanh(v0[j]); v1[j] = gelu_tanh(v1[j]); }
                    }
                    if (st) {
#pragma unroll
                        for (int j = 0; j < 4; ++j) { s1 += v0[j] + v1[j]; s2 += v0[j] * v0[j] + v1[j] * v1[j]; }
                    }
                    u32x4 w; w.x = cvt_pk_bf16(v0[0], v0[1]); w.y = cvt_pk_bf16(v0[2], v0[3]); w.z = cvt_pk_bf16(v1[0], v1[1]); w.w = cvt_pk_bf16(v1[2], v1[3]);
                    __builtin_nontemporal_store(w, (u32x4*)(rowp + bj * HALF));
                }
                if (st && lnstat) {
                    s1 += __shfl_xor(s1, 16); s1 += __shfl_xor(s1, 32); s2 += __shfl_xor(s2, 16); s2 += __shfl_xor(s2, 32);
                    if (fq == 0) { unsafeAtomicAdd(lnstat + 2 * row, s1); unsafeAtomicAdd(lnstat + 2 * row + 1, s2); }
                }
            }
    }
};
struct EpiOut {
    static constexpr bool PERM = false, AFTER_DRAIN = false, MID = false, MIDLOOP = true;
    bf16_t* x1b; float* ss2; const PG8_LAS f32x2* sct;
    __device__ __forceinline__ void midloop(f32x4 (&acc)[2][2][4][2], const Unit& u, int wr, int fr) const {
        const PG8_LAS f32x2* p = sct + u.slot * 256 + wr * 64 + fr;
#pragma unroll
        for (int ai = 0; ai < 2; ++ai)
#pragma unroll
            for (int m = 0; m < 4; ++m) {
                const float ratio = p[ai * HALF + m * 16][0];
#pragma unroll
                for (int bj = 0; bj < 2; ++bj)
#pragma unroll
                    for (int n = 0; n < 2; ++n) acc[ai][bj][m][n] *= ratio;
            }
    }
    __device__ __forceinline__ void operator()(const f32x4 (&acc)[2][2][4][2], const Unit& u, int wr, int wc, int fr, int fq) const {
        const int row0 = u.pm * BM + wr * 64 + fr, col0 = u.pn * BM + wc * 32 + 4 * fq;
        const PG8_LAS f32x2* p = sct + u.slot * 256 + wr * 64 + fr;
#pragma unroll
        for (int ai = 0; ai < 2; ++ai)
#pragma unroll
            for (int m = 0; m < 4; ++m) {
                const int row = row0 + ai * HALF + m * 16; const float rg = p[ai * HALF + m * 16][1];
                bf16_t* brow = x1b + (size_t)row * DM + col0; float sq = 0.f;
#pragma unroll
                for (int bj = 0; bj < 2; ++bj)
#pragma unroll
                    for (int n = 0; n < 2; ++n) {
                        const u32x2 xw = *(const u32x2*)(brow + bj * HALF + n * 16);
                        f32x4 v = acc[ai][bj][m][n] * rg;
                        v[0] += __builtin_bit_cast(float, xw.x << 16); v[1] += __builtin_bit_cast(float, xw.x & 0xffff0000u); v[2] += __builtin_bit_cast(float, xw.y << 16); v[3] += __builtin_bit_cast(float, xw.y & 0xffff0000u);
                        u32x2 w; w.x = cvt_pk_bf16(v[0], v[1]); w.y = cvt_pk_bf16(v[2], v[3]); *(u32x2*)(brow + bj * HALF + n * 16) = w;
                        sq += (v[0] * v[0] + v[1] * v[1]) + (v[2] * v[2] + v[3] * v[3]);
                    }
                sq += __shfl_xor(sq, 16); sq += __shfl_xor(sq, 32);
                if (fq == 0) unsafeAtomicAdd(ss2 + row, sq);
            }
    }
};
struct EpiUp {
    static constexpr bool PERM = true, AFTER_DRAIN = false, MID = false, MIDLOOP = false;
    bf16_t* H; const float* ss2;
    __device__ __forceinline__ void operator()(const f32x4 (&acc)[2][2][4][2], const Unit& u, int wr, int wc, int fr, int fq) const {
        const int row0 = u.pm * BM + wr * 64 + fr, col0 = u.pn * BM + wc * 32 + 8 * fq;
#pragma unroll
        for (int ai = 0; ai < 2; ++ai)
#pragma unroll
            for (int m = 0; m < 4; ++m) {
                const int row = row0 + ai * HALF + m * 16; const float rs = 1.0f / sqrtf(__hip_atomic_load(ss2 + row, __ATOMIC_RELAXED, __HIP_MEMORY_SCOPE_AGENT) * (1.0f / 2048.0f) + EPSN);
                bf16_t* rowp = H + (size_t)row * DFF + col0;
#pragma unroll
                for (int bj = 0; bj < 2; ++bj) {
                    f32x4 v0 = acc[ai][bj][m][0] * rs, v1 = acc[ai][bj][m][1] * rs;
#pragma unroll
                    for (int j = 0; j < 4; ++j) { v0[j] = fmaxf(v0[j], 0.f); v0[j] *= v0[j]; v1[j] = fmaxf(v1[j], 0.f); v1[j] *= v1[j]; }
                    u32x4 w; w.x = cvt_pk_bf16(v0[0], v0[1]); w.y = cvt_pk_bf16(v0[2], v0[3]); w.z = cvt_pk_bf16(v1[0], v1[1]); w.w = cvt_pk_bf16(v1[2], v1[3]);
                    *(u32x4*)(rowp + bj * HALF) = w;
                }
            }
    }
};
struct EpiDown {
    static constexpr bool PERM = false, AFTER_DRAIN = false, MID = false, MIDLOOP = false;
    float* out; const bf16_t* x1b;
    __device__ __forceinline__ void operator()(const f32x4 (&acc)[2][2][4][2], const Unit& u, int wr, int wc, int fr, int fq) const {
        const int row0 = u.pm * BM + wr * 64 + fr, col0 = u.pn * BM + wc * 32 + 4 * fq;
#pragma unroll
        for (int ai = 0; ai < 2; ++ai)
#pragma unroll
            for (int m = 0; m < 4; ++m) {
                const size_t off = (size_t)(row0 + ai * HALF + m * 16) * DM + col0;
#pragma unroll
                for (int bj = 0; bj < 2; ++bj)
#pragma unroll
                    for (int n = 0; n < 2; ++n) { const u32x2 xw = *(const u32x2*)(x1b + off + bj * HALF + n * 16); f32x4 v = acc[ai][bj][m][n];
                        v[0] += __builtin_bit_cast(float, xw.x << 16); v[1] += __builtin_bit_cast(float, xw.x & 0xffff0000u); v[2] += __builtin_bit_cast(float, xw.y << 16); v[3] += __builtin_bit_cast(float, xw.y & 0xffff0000u);
                        __builtin_nontemporal_store(v, (f32x4*)(out + off + bj * HALF + n * 16)); }
            }
    }
};

template <class Epi, class Sched, bool ALIGN_EPI = false, bool SP2 = false>
__device__ __forceinline__ void gemm_phase(PG8_LAS unsigned char* lds, const Gemm g, const Sched& S, const Epi& E) {
    int tid_ = threadIdx.x; asm volatile("" : "+v"(tid_));
    const int tid = tid_, wid = __builtin_amdgcn_readfirstlane(tid >> 6), lane = tid & 63, wr = wid >> 2, wc = wid & 3, fr = lane & 15, fq = lane >> 4;
    const int K = g.K, nt = K / BK, LD = g.ld;
    unsigned voffA[2], voffB[2];
#pragma unroll
    for (int i = 0; i < 2; ++i) { int R, C; stage_rc(tid * 16 + i * 8192, R, C); const int Rb = Epi::PERM ? ((R & ~31) + perm32(R & 31)) : R;
        voffA[i] = (unsigned)(R * LD + C) * 2u; voffB[i] = (unsigned)(Rb * LD + C) * 2u; }
    const size_t kstep = (size_t)(BK * 2);
    const size_t hstep = (size_t)HALF * LD * 2;
    const size_t tstep = 2 * hstep;
    const unsigned ldsw = (unsigned)wid * 1024u;
    const int aoff = lds_byte(wr * 64 + fr, fq * 8), boff = lds_byte(wc * 32 + fr, fq * 8);
#define PG8_SA(b, h) (((b) * 2 + (h)) * HTB)
#define PG8_SB(b, h) ((4 + (b) * 2 + (h)) * HTB)
#define PG8_STAGE(bufoff, gbase, voff) do { _Pragma("unroll") for (int _i = 0; _i < 2; ++_i) \
        __builtin_amdgcn_global_load_lds((const unsigned*)((const char*)(gbase) + (voff)[_i]), (PG8_LAS unsigned*)(lds + (bufoff) + ldsw + _i * 8192), 16, 0, 0); } while (0)
#define PG8_LDA(dst, b, h) do { _Pragma("unroll") for (int m = 0; m < 4; ++m) _Pragma("unroll") for (int k = 0; k < 2; ++k) dst[m][k] = *(const PG8_LAS bf16x8*)(lds + PG8_SA(b, h) + aoff + m * 2048 + k * 1024); } while (0)
#define PG8_LDB(dst, b, h) do { _Pragma("unroll") for (int n = 0; n < 2; ++n) _Pragma("unroll") for (int k = 0; k < 2; ++k) dst[n][k] = *(const PG8_LAS bf16x8*)(lds + PG8_SB(b, h) + boff + n * 2048 + k * 1024); } while (0)
#define PG8_MMA(ai, bj, At, Bt) do { __builtin_amdgcn_s_setprio(1); _Pragma("unroll") for (int m = 0; m < 4; ++m) _Pragma("unroll") for (int n = 0; n < 2; ++n) _Pragma("unroll") for (int k = 0; k < 2; ++k) \
        acc[ai][bj][m][n] = __builtin_amdgcn_mfma_f32_16x16x32_bf16(Bt[n][k], At[m][k], acc[ai][bj][m][n], 0, 0, 0); __builtin_amdgcn_s_setprio(0); } while (0)
#define PG8_WAIT_V(n) asm volatile("s_waitcnt vmcnt(" #n ")" ::: "memory")
#define PG8_WAIT_L(n) asm volatile("s_waitcnt lgkmcnt(" #n ")" ::: "memory")
#define PG8_BAR __builtin_amdgcn_s_barrier()
#define PG8_SCHED __builtin_amdgcn_sched_barrier(0)
    Unit cur, nxt; int ui = 0;
    if (!S.next(0, cur)) return;
    f32x4 acc[2][2][4][2];
#pragma unroll
    for (int a = 0; a < 2; ++a)
#pragma unroll
        for (int b = 0; b < 2; ++b)
#pragma unroll
            for (int m = 0; m < 4; ++m)
#pragma unroll
                for (int n = 0; n < 2; ++n) acc[a][b][m][n] = (f32x4){0.f, 0.f, 0.f, 0.f};
    bf16x8 At[4][2], B0[2][2], B1[2][2];
    const size_t khstep = (size_t)K * 2;
    const char* cA = (const char*)g.A + (size_t)cur.pm * tstep + cur.kh * khstep; const char* cB = (const char*)g.Bt + (size_t)cur.pn * tstep + cur.kh * khstep;
    S.a_ready(cur);
    if constexpr (SP2) {
        PG8_STAGE(PG8_SB(0, 0), cB, voffB); PG8_STAGE(PG8_SB(0, 1), cB + hstep, voffB); PG8_STAGE(PG8_SA(0, 0), cA, voffA); PG8_STAGE(PG8_SA(0, 1), cA + hstep, voffA);
        if (wr == 1) PG8_BAR;
        PG8_WAIT_V(2); PG8_BAR;
        PG8_STAGE(PG8_SB(1, 0), cB + kstep, voffB); PG8_STAGE(PG8_SA(1, 0), cA + kstep, voffA); PG8_STAGE(PG8_SB(1, 1), cB + hstep + kstep, voffB);
        PG8_WAIT_V(6); PG8_BAR;
    } else {
        PG8_STAGE(PG8_SB(0, 0), cB, voffB); PG8_STAGE(PG8_SA(0, 0), cA, voffA); PG8_STAGE(PG8_SB(0, 1), cB + hstep, voffB); PG8_STAGE(PG8_SA(0, 1), cA + hstep, voffA);
        if (wr == 1) PG8_BAR;
        PG8_WAIT_V(4); PG8_BAR;
        PG8_STAGE(PG8_SB(1, 0), cB + kstep, voffB); PG8_STAGE(PG8_SA(1, 0), cA + kstep, voffA); PG8_STAGE(PG8_SB(1, 1), cB + hstep + kstep, voffB);
        PG8_WAIT_V(6); PG8_BAR;
    }
    for (;;) {
        const bool has_next = S.next(ui + 1, nxt);
        const char* nA = has_next ? (const char*)g.A + (size_t)nxt.pm * tstep + nxt.kh * khstep : cA; const char* nB = has_next ? (const char*)g.Bt + (size_t)nxt.pn * tstep + nxt.kh * khstep : cB;
        for (int t = 0; t < nt; t += 2) {
            const bool last = (t == nt - 2);
            const char* a1 = cA + (size_t)(t + 1) * kstep;
            const char* a2 = last ? nA : cA + (size_t)(t + 2) * kstep; const char* b2 = last ? nB : cB + (size_t)(t + 2) * kstep;
            const char* a3 = a2 + kstep; const char* b3 = b2 + kstep;
            if (last && has_next) S.a_ready(nxt);
            if constexpr (Epi::MIDLOOP) { if (t == (nt >> 1)) E.midloop(acc, cur, wr, fr); }
            if constexpr (SP2) {
            PG8_LDB(B0, 0, 0); PG8_LDB(B1, 0, 1); PG8_SCHED; PG8_LDA(At, 0, 0); PG8_STAGE(PG8_SA(1, 1), a1 + hstep, voffA);
            PG8_WAIT_V(8); PG8_WAIT_L(0); PG8_BAR; PG8_MMA(0, 0, At, B0); PG8_MMA(0, 1, At, B1); PG8_BAR; PG8_SCHED;
            PG8_LDA(At, 0, 1); PG8_STAGE(PG8_SB(0, 0), b2, voffB); PG8_STAGE(PG8_SB(0, 1), b2 + hstep, voffB); PG8_STAGE(PG8_SA(0, 0), a2, voffA);
            PG8_WAIT_V(8); PG8_WAIT_L(0); PG8_BAR; PG8_MMA(1, 0, At, B0); PG8_MMA(1, 1, At, B1); PG8_BAR; PG8_SCHED;
            PG8_LDB(B0, 1, 0); PG8_LDB(B1, 1, 1); PG8_SCHED; PG8_LDA(At, 1, 0); PG8_STAGE(PG8_SA(0, 1), a2 + hstep, voffA);
            PG8_WAIT_V(8); PG8_WAIT_L(0); PG8_BAR; PG8_MMA(0, 0, At, B0); PG8_MMA(0, 1, At, B1); PG8_BAR; PG8_SCHED;
            PG8_LDA(At, 1, 1); PG8_STAGE(PG8_SB(1, 0), b3, voffB); PG8_STAGE(PG8_SB(1, 1), b3 + hstep, voffB); PG8_STAGE(PG8_SA(1, 0), a3, voffA);
            PG8_WAIT_V(8); PG8_WAIT_L(0); PG8_BAR; PG8_MMA(1, 0, At, B0); PG8_MMA(1, 1, At, B1); PG8_BAR; PG8_SCHED;
            } else {
            PG8_LDB(B0, 0, 0); PG8_SCHED; PG8_LDA(At, 0, 0); PG8_STAGE(PG8_SA(1, 1), a1 + hstep, voffA);
            PG8_WAIT_L(8); PG8_BAR; PG8_WAIT_L(0); PG8_MMA(0, 0, At, B0); PG8_BAR; PG8_SCHED;
            PG8_LDB(B1, 0, 1); PG8_STAGE(PG8_SB(0, 0), b2, voffB);
            PG8_BAR; PG8_WAIT_L(0); PG8_MMA(0, 1, At, B1); PG8_BAR;
            PG8_LDA(At, 0, 1); PG8_STAGE(PG8_SA(0, 0), a2, voffA);
            PG8_BAR; PG8_WAIT_L(0); PG8_MMA(1, 0, At, B0); PG8_BAR; PG8_SCHED;
            PG8_STAGE(PG8_SB(0, 1), b2 + hstep, voffB);
            PG8_WAIT_V(6); PG8_BAR; PG8_MMA(1, 1, At, B1); PG8_BAR;
            PG8_LDB(B0, 1, 0); PG8_SCHED; PG8_LDA(At, 1, 0); PG8_STAGE(PG8_SA(0, 1), a2 + hstep, voffA);
            PG8_WAIT_L(8); PG8_BAR; PG8_WAIT_L(0); PG8_MMA(0, 0, At, B0); PG8_BAR; PG8_SCHED;
            PG8_LDB(B1, 1, 1); PG8_STAGE(PG8_SB(1, 0), b3, voffB);
            PG8_BAR; PG8_WAIT_L(0); PG8_MMA(0, 1, At, B1); PG8_BAR;
            PG8_LDA(At, 1, 1); PG8_STAGE(PG8_SA(1, 0), a3, voffA);
            PG8_BAR; PG8_WAIT_L(0); PG8_MMA(1, 0, At, B0); PG8_BAR; PG8_SCHED;
            PG8_STAGE(PG8_SB(1, 1), b3 + hstep, voffB);
            PG8_WAIT_V(6); PG8_BAR; PG8_MMA(1, 1, At, B1); PG8_BAR;
            }
        }
        if constexpr (ALIGN_EPI) { if (wr == 0) PG8_BAR; }
        bool keep = false;
        if constexpr (Epi::MID) { if (cur.kh == 0) { E.mid(acc, cur, wr, wc, fr, fq); keep = true; } else E(acc, cur, wr, wc, fr, fq); }
        else if constexpr (!Epi::AFTER_DRAIN) { E(acc, cur, wr, wc, fr, fq); S.done(cur); }
        if (!has_next) break;
        if (!keep) {
#pragma unroll
        for (int a = 0; a < 2; ++a)
#pragma unroll
            for (int b = 0; b < 2; ++b)
#pragma unroll
                for (int m = 0; m < 4; ++m)
#pragma unroll
                    for (int n = 0; n < 2; ++n) acc[a][b][m][n] = (f32x4){0.f, 0.f, 0.f, 0.f};
        }
        cur = nxt; cA = nA; cB = nB; ++ui;
        if constexpr (ALIGN_EPI) { if (wr == 1) PG8_BAR; }
    }
    PG8_WAIT_V(0);
    if constexpr (!ALIGN_EPI) { if (wr == 0) PG8_BAR; }
    PG8_BAR;
    if constexpr (Epi::AFTER_DRAIN) { E.fused(acc, cur, wr, wc, fr, fq, lds, wid, lane); S.done(cur); }
#undef PG8_SA
#undef PG8_SB
#undef PG8_STAGE
#undef PG8_LDA
#undef PG8_LDB
#undef PG8_MMA
#undef PG8_WAIT_V
#undef PG8_WAIT_L
#undef PG8_BAR
#undef PG8_SCHED
}
}

#define LAS __attribute__((address_space(3)))
typedef unsigned short bf16;
typedef float f32x4 __attribute__((ext_vector_type(4)));
typedef short bf16x8 __attribute__((ext_vector_type(8)));
typedef short s16x4 __attribute__((ext_vector_type(4)));
typedef unsigned v4u __attribute__((ext_vector_type(4)));
typedef unsigned v2u __attribute__((ext_vector_type(2)));
typedef float f32x2 __attribute__((ext_vector_type(2)));
constexpr int NW = 8, NT = 512;
constexpr int T = 16384, D = 2048, INW = 3584, FF = 8192, TH = 8192;
constexpr int LDS_BYTES = 147456, LDS_BARST = LDS_BYTES - 64;
constexpr size_t MiB = 1u << 20;
constexpr size_t WS_BAR = 2 * MiB + 65536  , WS_PAR = 2 * MiB, WS_LNSTAT = 0, WS_SS2 = 131072, WS_R1 = 196608, WS_SSMIX = 262144, WS_TAB = 1310720, WS_WSP = 1835008;
constexpr size_t WS_WIN = 3 * MiB, WS_WOUT = 17 * MiB, WS_WUP = 25 * MiB, WS_WDOWN = 57 * MiB, WS_XB = 89 * MiB, WS_HID = 153 * MiB, WS_MIX = 153 * MiB, WS_END = 281 * MiB;
constexpr int PAR_GQ = 0, PAR_GK = 128, PAR_SINK = 256, PAR_GV = 512, PAR_BV = 1536, PAR_BSP = 2560, PAR_N = 3584;
constexpr int C_Q = 0, C_K = 1024, C_V = 1280, C_U = 1536, C_VG = 2560;
constexpr int QK_STRIDE = 272, V_STRIDE = 288;
constexpr int LQ = 0, LK = 2 * 128 * QK_STRIDE, LV = LK + 128 * QK_STRIDE;
static_assert(LV + 128 * V_STRIDE <= LDS_BYTES, "attention LDS");
constexpr float LOG2E = 1.4426950408889634f;

__device__ __forceinline__ unsigned f2bf(float f) { unsigned u = __builtin_bit_cast(unsigned, f); return (u + 0x7fffu + ((u >> 16) & 1u)) >> 16; }
__device__ __forceinline__ unsigned pk2(float lo, float hi) { return pg8::cvt_pk_bf16(lo, hi); }
__device__ __forceinline__ float bflo(unsigned w) { return __builtin_bit_cast(float, w << 16); }
__device__ __forceinline__ float bfhi(unsigned w) { return __builtin_bit_cast(float, w & 0xffff0000u); }
__device__ __forceinline__ float wave_sum(float v) {
#pragma unroll
    for (int o = 1; o < 64; o <<= 1) v += __shfl_xor(v, o);
    return v;
}
#define LDS_WAIT() asm volatile("s_waitcnt lgkmcnt(0)" ::: "memory")

#define RLX_AGENT __ATOMIC_RELAXED, __HIP_MEMORY_SCOPE_AGENT
#define XB_TMO      128
#define XB_XCNT(j)  (256  + 64 * (j))
#define XB_XSUB(j)  (1280 + 64 * (j))
#define XB_XGEN(j)  (2304 + 64 * (j))
#define XB_TOP      3328
#define XB_TOPGEN   3392
#define XCD_BAR_WORDS 3456
#define XB_SPIN_CAP (1u << 18)

__device__ __forceinline__ unsigned xb_ld(unsigned* p)              { return __hip_atomic_load(p, __ATOMIC_RELAXED, __HIP_MEMORY_SCOPE_AGENT); }
__device__ __forceinline__ unsigned xb_add(unsigned* p, unsigned v) { return __hip_atomic_fetch_add(p, v, __ATOMIC_RELAXED, __HIP_MEMORY_SCOPE_AGENT); }
__device__ __forceinline__ unsigned xb_xcc_id() { return (unsigned)__builtin_amdgcn_s_getreg((3 << 11) | 20) & 0xFu; }
#define XB_SPIN(cond, bar) do { unsigned _sp = 0; while (cond) { __builtin_amdgcn_s_sleep(1); \
    if ((++_sp & 255u) == 0u) { if (xb_ld(&(bar)[XB_TMO])) break; if (_sp > XB_SPIN_CAP) { atomicAdd(&(bar)[XB_TMO], 1u); break; } } } } while (0)

struct XcdBarrier {
    unsigned* bar; unsigned x;
    volatile LAS unsigned* st;
};

__device__ __forceinline__ XcdBarrier xcd_barrier_post(unsigned* bar, volatile LAS unsigned* st) {
    XcdBarrier b; b.bar = bar; b.x = xb_xcc_id(); b.st = st;
    if (threadIdx.x == 0) (void)xb_add(&bar[XB_XCNT(b.x)], 1u);
    return b;
}
__device__ __forceinline__ void xcd_barrier_complete(unsigned* bar, unsigned x, unsigned& nloc, unsigned& nx) {
    const unsigned G = gridDim.x * gridDim.y * gridDim.z;
    unsigned sum, cnt, mine, sp = 0u;
    for (;;) {
        sum = 0u; cnt = 0u; mine = 0u;
#pragma unroll
        for (unsigned j = 0; j < 16; ++j) { const unsigned c = xb_ld(&bar[XB_XCNT(j)]); sum += c; cnt += (c > 0u) ? 1u : 0u; mine = (j == x) ? c : mine; }
        if (sum == G) break;
        __builtin_amdgcn_s_sleep(1);
        if ((++sp & 255u) == 0u) { if (xb_ld(&bar[XB_TMO])) break; if (sp > XB_SPIN_CAP) { atomicAdd(&bar[XB_TMO], 1u); break; } }
    }
    nloc = mine > 0u ? mine : 1u; nx = cnt > 0u ? cnt : 1u;
}

__device__ __forceinline__ void xcd_barrier(const XcdBarrier& b) {
    asm volatile("s_waitcnt vmcnt(0)" ::: "memory");
    __syncthreads();
    if (threadIdx.x == 0) {
        unsigned* bar = b.bar;
        __builtin_amdgcn_s_waitcnt(0);
        unsigned nloc = b.st[0], nx = b.st[1];
        if (nloc == 0u) { xcd_barrier_complete(bar, b.x, nloc, nx); b.st[0] = nloc; b.st[1] = nx; }
        const unsigned old = xb_add(&bar[XB_XSUB(b.x)], 1u);
        const unsigned gen = old / nloc;
        if (old + 1u == (gen + 1u) * nloc) {
            __builtin_amdgcn_fence(__ATOMIC_RELEASE, "agent");
            asm volatile("s_waitcnt vmcnt(0)" ::: "memory");
            const unsigned og = xb_add(&bar[XB_TOP], 1u);
            const unsigned tg = og / nx;
            if (og + 1u == (tg + 1u) * nx) xb_add(&bar[XB_TOPGEN], 1u);
            else XB_SPIN(xb_ld(&bar[XB_TOPGEN]) == tg, bar);
            __builtin_amdgcn_fence(__ATOMIC_ACQUIRE, "agent");
            xb_add(&bar[XB_XGEN(b.x)], 1u);
            asm volatile("s_waitcnt vmcnt(0)" ::: "memory");
        } else {
            XB_SPIN(xb_ld(&bar[XB_XGEN(b.x)]) == gen, bar);
            __builtin_amdgcn_fence(__ATOMIC_ACQUIRE, "agent");
            asm volatile("s_waitcnt vmcnt(0)" ::: "memory");
        }
    }
    __syncthreads();
}


#define XB_LOC_ARR(j) (XCD_BAR_WORDS + 64 * (j))
#define XB_LOC_GEN(j) (XCD_BAR_WORDS + 4096 + 64 * (j))
#define XCD_BAR_WORDS_ALL (XCD_BAR_WORDS + 8192)
__device__ __forceinline__ void xcd_local_barrier(const XcdBarrier& b, int team = -1, unsigned tsz = 0) {
    asm volatile("s_waitcnt vmcnt(0)" ::: "memory");
    __syncthreads();
    if (threadIdx.x == 0) {
        unsigned* bar = b.bar;
        __builtin_amdgcn_s_waitcnt(0);
        const unsigned nloc = (team >= 0) ? tsz : b.st[0];
        const unsigned slot = (team >= 0) ? 16u + b.x * 4u + (unsigned)team : b.x;
        const unsigned old = xb_add(&bar[XB_LOC_ARR(slot)], 1u), gen = old / nloc;
        if (old + 1u == (gen + 1u) * nloc) xb_add(&bar[XB_LOC_GEN(slot)], 1u);
        else XB_SPIN(xb_ld(&bar[XB_LOC_GEN(slot)]) == gen, bar);
        __builtin_amdgcn_fence(__ATOMIC_ACQUIRE, "agent");
        asm volatile("s_waitcnt vmcnt(0)" ::: "memory");
    }
    __syncthreads();
}

struct Args {
    const float *xp, *xs, *g_mix, *w_in, *g_q, *g_k, *sink, *g_v_ln, *b_v_ln, *w_sp, *b_sp, *g_ao, *g_go, *w_out, *g_ffn, *w_up, *w_down;
    float* out; unsigned char* ws;
};

__device__ __forceinline__ void transpose_tile(const float* __restrict__ W, int K, int N, bf16* __restrict__ WT, const float* __restrict__ ga, const float* __restrict__ gb, int gsplit, LAS float* scr, int item, int lane) {
    const int nkb = K / 64, nb = item / nkb, kb = item % nkb, k0 = 64 * kb, n0 = 64 * nb;
    const int c = lane & 15, kq = lane >> 4;
    f32x4 v[16];
#pragma unroll
    for (int i = 0; i < 16; ++i) v[i] = __builtin_nontemporal_load((const f32x4*)(W + (size_t)(k0 + 4 * i + kq) * N + n0 + 4 * c));
#pragma unroll
    for (int i = 0; i < 16; ++i) {
        const int k = k0 + 4 * i + kq; float g = 1.0f; if (ga) g = (k < gsplit) ? ga[k] : gb[k - gsplit];
        LAS float* p = scr + (4 * i + kq) * 65 + 4 * c; p[0] = v[i][0] * g; p[1] = v[i][1] * g; p[2] = v[i][2] * g; p[3] = v[i][3] * g;
    }
    LDS_WAIT(); asm volatile("" ::: "memory");
    const int kc = lane & 7;
#pragma unroll
    for (int j = 0; j < 8; ++j) { const int n = (lane >> 3) + 8 * j; const LAS float* sp = scr + (8 * kc) * 65 + n;
        v4u o; o.x = pk2(sp[0 * 65], sp[1 * 65]); o.y = pk2(sp[2 * 65], sp[3 * 65]); o.z = pk2(sp[4 * 65], sp[5 * 65]); o.w = pk2(sp[6 * 65], sp[7 * 65]);
        *(v4u*)(WT + (size_t)(n0 + n) * K + k0 + 8 * kc) = o; }
    LDS_WAIT(); asm volatile("" ::: "memory");
}

__device__ __forceinline__ bf16x8 tr_frag(const LAS unsigned char* p0, const LAS unsigned char* p1) {
    const s16x4 a = __builtin_amdgcn_ds_read_tr16_b64_v4i16((LAS s16x4*)p0);
    const s16x4 b = __builtin_amdgcn_ds_read_tr16_b64_v4i16((LAS s16x4*)p1);
    return __builtin_shufflevector(a, b, 0, 1, 2, 3, 4, 5, 6, 7);
}
__device__ __forceinline__ void tile_ld(v4u (&raw)[4], const bf16* proj, int tok0, int colbase, int tid) {
    const int c = tid & 15, r0 = tid >> 4;
#pragma unroll
    for (int p = 0; p < 4; ++p) raw[p] = *(const v4u*)(proj + (size_t)(tok0 + r0 + 32 * p) * INW + colbase + 8 * c);
}
template <int STRIDE> __device__ __forceinline__ void tile_st(const v4u (&raw)[4], LAS unsigned char* dst, int tid) {
    const int c = tid & 15, r0 = tid >> 4;
#pragma unroll
    for (int p = 0; p < 4; ++p) *(LAS v4u*)(dst + (r0 + 32 * p) * STRIDE + c * 16) = raw[p];
}

__device__ __forceinline__ void attn_unit(const bf16* proj, unsigned char* ws, LAS unsigned char* lds, int a) {
    int tid = threadIdx.x; asm volatile("" : "+v"(tid)); const int lane = tid & 63, wave = __builtin_amdgcn_readfirstlane(tid >> 6);
    const float* par = (const float*)(ws + WS_PAR);
    bf16* mix = (bf16*)(ws + WS_MIX); float* ssmix = (float*)(ws + WS_SSMIX);
    const int gb = a >> 2, kvh = (a >> 1) & 1, hp = a & 1;
    int n, nb; if (gb < 64) { nb = 32; n = gb & 31; } else { nb = 16; n = (gb - 64) & 15; }
    const int tok0 = gb * 128, hw = wave >> 2, rq = wave & 3, fr = lane & 15, fq = lane >> 4;
    const int h0 = kvh * 4 + hp * 2, h = h0 + hw;
    LAS unsigned char* QS = lds + LQ; LAS unsigned char* KS = lds + LK; LAS unsigned char* VS = lds + LV;
    const int kb0 = (n > 0) ? n - 1 : 0, kb1 = (n + 1 < nb) ? n + 1 : nb - 1;
    v4u kr[4], vr[4];
    {
        v4u q0[4], q1[4];
        tile_ld(q0, proj, tok0, C_Q + h0 * 128, tid); tile_ld(q1, proj, tok0, C_Q + (h0 + 1) * 128, tid);
        tile_ld(kr, proj, tok0 + (kb0 - n) * 128, C_K + kvh * 128, tid); tile_ld(vr, proj, tok0 + (kb0 - n) * 128, C_V + kvh * 128, tid);
        __syncthreads();
        tile_st<QK_STRIDE>(q0, QS, tid); tile_st<QK_STRIDE>(q1, QS + 128 * QK_STRIDE, tid);
    }
    const LAS unsigned char* qbase = QS + hw * (128 * QK_STRIDE) + (rq * 32 + fr) * QK_STRIDE + (8 * fq) * 2;
    const float sk2 = par[PAR_SINK + h] * LOG2E;
    float mrow[2], lrow[2]; mrow[0] = mrow[1] = sk2; lrow[0] = lrow[1] = (fq == 0) ? 1.0f : 0.0f;
    f32x4 O[2][8];
#pragma unroll
    for (int rt = 0; rt < 2; ++rt)
#pragma unroll
        for (int dt = 0; dt < 8; ++dt) O[rt][dt] = (f32x4){0.f, 0.f, 0.f, 0.f};
#pragma unroll 1
    for (int kb = kb0; kb <= kb1; ++kb) {
        if (kb != kb0) __syncthreads();
        tile_st<QK_STRIDE>(kr, KS, tid); tile_st<V_STRIDE>(vr, VS, tid);
        __syncthreads();
        if (kb < kb1) { tile_ld(kr, proj, tok0 + (kb + 1 - n) * 128, C_K + kvh * 128, tid); tile_ld(vr, proj, tok0 + (kb + 1 - n) * 128, C_V + kvh * 128, tid); }
        f32x4 st[2][8];
#pragma unroll
        for (int kt = 0; kt < 8; ++kt) { st[0][kt] = (f32x4){0.f, 0.f, 0.f, 0.f}; st[1][kt] = (f32x4){0.f, 0.f, 0.f, 0.f}; }
#pragma unroll
        for (int s = 0; s < 4; ++s) {
            const bf16x8 qa = *(const LAS bf16x8*)(qbase + 64 * s), qb = *(const LAS bf16x8*)(qbase + 16 * QK_STRIDE + 64 * s);
#pragma unroll
            for (int kt = 0; kt < 8; ++kt) {
                const bf16x8 kf = *(const LAS bf16x8*)(KS + (16 * kt + fr) * QK_STRIDE + (32 * s + 8 * fq) * 2);
                st[0][kt] = __builtin_amdgcn_mfma_f32_16x16x32_bf16(kf, qa, st[0][kt], 0, 0, 0);
                st[1][kt] = __builtin_amdgcn_mfma_f32_16x16x32_bf16(kf, qb, st[1][kt], 0, 0, 0);
            }
        }
        bf16x8 pb[2][4];
#pragma unroll
        for (int rt = 0; rt < 2; ++rt) {
            const int qi = rq * 32 + rt * 16 + fr;
            if (kb != n) {
                const int sgn = (kb < n) ? 1 : -1, dbase = sgn * (4 * fq - qi);
#pragma unroll
                for (int kt = 0; kt < 8; ++kt)
#pragma unroll
                    for (int r = 0; r < 4; ++r) { const int dd = dbase + sgn * (16 * kt + r); st[rt][kt][r] += __builtin_bit_cast(float, (unsigned)(dd >> 31) & 0xF149F2CAu); }
            }
            float mx = -1e30f;
#pragma unroll
            for (int kt = 0; kt < 8; ++kt)
#pragma unroll
                for (int r = 0; r < 4; ++r) mx = fmaxf(mx, st[rt][kt][r]);
            mx = fmaxf(mx, __shfl_xor(mx, 16)); mx = fmaxf(mx, __shfl_xor(mx, 32));
            const float mnew = fmaxf(mrow[rt], mx), alpha = __builtin_amdgcn_exp2f(mrow[rt] - mnew);
            mrow[rt] = mnew; float ls = lrow[rt] * alpha;
#pragma unroll
            for (int dt = 0; dt < 8; ++dt) O[rt][dt] *= alpha;
#pragma unroll
            for (int kt = 0; kt < 8; ++kt)
#pragma unroll
                for (int r = 0; r < 4; ++r) { const float p = __builtin_amdgcn_exp2f(st[rt][kt][r] - mnew); st[rt][kt][r] = p; ls += p; }
            lrow[rt] = ls;
#pragma unroll
            for (int tp = 0; tp < 4; ++tp) {
                v4u w; w.x = pk2(st[rt][2 * tp][0], st[rt][2 * tp][1]); w.y = pk2(st[rt][2 * tp][2], st[rt][2 * tp][3]);
                w.z = pk2(st[rt][2 * tp + 1][0], st[rt][2 * tp + 1][1]); w.w = pk2(st[rt][2 * tp + 1][2], st[rt][2 * tp + 1][3]);
                pb[rt][tp] = __builtin_bit_cast(bf16x8, w);
            }
        }
#pragma unroll
        for (int dt = 0; dt < 8; ++dt)
#pragma unroll
            for (int tp = 0; tp < 4; ++tp) {
                const LAS unsigned char* p0 = VS + (32 * tp + 4 * fq + (fr >> 2)) * V_STRIDE + (16 * dt + 4 * (fr & 3)) * 2;
                const bf16x8 vf = tr_frag(p0, p0 + 16 * V_STRIDE);
                O[0][dt] = __builtin_amdgcn_mfma_f32_16x16x32_bf16(vf, pb[0][tp], O[0][dt], 0, 0, 0);
                O[1][dt] = __builtin_amdgcn_mfma_f32_16x16x32_bf16(vf, pb[1][tp], O[1][dt], 0, 0, 0);
            }
    }
#pragma unroll
    for (int rt = 0; rt < 2; ++rt) {
        float lt = lrow[rt]; lt += __shfl_xor(lt, 16); lt += __shfl_xor(lt, 32);
        const float inv = 1.0f / lt; const int tok = tok0 + rq * 32 + rt * 16 + fr; float ss = 0.f;
        bf16* orow = mix + (size_t)tok * D + h * 128 + 4 * fq;
#pragma unroll
        for (int dt = 0; dt < 8; ++dt) { const f32x4 o = O[rt][dt] * inv; ss += (o[0] * o[0] + o[1] * o[1]) + (o[2] * o[2] + o[3] * o[3]);
            v2u w; w.x = pk2(o[0], o[1]); w.y = pk2(o[2], o[3]); *(v2u*)(orow + 16 * dt) = w; }
        ss += __shfl_xor(ss, 16); ss += __shfl_xor(ss, 32);
        if (fq == 0) unsafeAtomicAdd(ssmix + (size_t)tok * 2, ss);
    }
}

__device__ __forceinline__ void gmlp_unit(const bf16* proj, unsigned char* ws, LAS unsigned char* lds, int gu) {
    int tid = threadIdx.x; asm volatile("" : "+v"(tid)); const int lane = tid & 63, wave = __builtin_amdgcn_readfirstlane(tid >> 6);
    const float* par = (const float*)(ws + WS_PAR);
    const float* lnstat = (const float*)(ws + WS_LNSTAT); const bf16* wsp = (const bf16*)(ws + WS_WSP);
    bf16* mix = (bf16*)(ws + WS_MIX); float* ssmix = (float*)(ws + WS_SSMIX);
    const int gb = gu >> 3, h = gu & 7, tok0 = gb * 128, fr = lane & 15, fq = lane >> 4;
    LAS unsigned char* VN = lds;
    const int c = tid & 15, r0 = tid >> 4;
    v4u raw[4]; f32x2 stv[4];
    tile_ld(raw, proj, tok0, C_VG + h * 128, tid);
#pragma unroll
    for (int p = 0; p < 4; ++p) stv[p] = *(const f32x2*)(lnstat + 2 * (tok0 + r0 + 32 * p));
    const f32x4 g0 = *(const f32x4*)(par + PAR_GV + h * 128 + 8 * c), g1 = *(const f32x4*)(par + PAR_GV + h * 128 + 8 * c + 4);
    const f32x4 b0 = *(const f32x4*)(par + PAR_BV + h * 128 + 8 * c), b1 = *(const f32x4*)(par + PAR_BV + h * 128 + 8 * c + 4);
    bf16x8 wf[4];
#pragma unroll
    for (int s = 0; s < 4; ++s) wf[s] = *(const bf16x8*)(wsp + ((size_t)(h * 128 + 16 * wave + fr) * 128 + 32 * s + 8 * fq));
    const int tok = tok0 + 16 * wave + fr; const float bsp = par[PAR_BSP + h * 128 + 16 * wave + fr];
    const bf16* urow = proj + (size_t)tok * INW + C_U + h * 128 + 4 * fq; bf16* orow = mix + (size_t)tok * D + 1024 + h * 128 + 4 * fq;
    v2u uw[8];
#pragma unroll
    for (int ct = 0; ct < 8; ++ct) uw[ct] = *(const v2u*)(urow + 16 * ct);
    __syncthreads();
#pragma unroll
    for (int p = 0; p < 4; ++p) {
        const float mu = stv[p][0] * (1.0f / 1024.0f), var = fmaxf(stv[p][1] * (1.0f / 1024.0f) - mu * mu, 0.f), rstd = 1.0f / sqrtf(var + pg8::EPSN);
        float v[8];
        v[0] = bflo(raw[p].x); v[1] = bfhi(raw[p].x); v[2] = bflo(raw[p].y); v[3] = bfhi(raw[p].y); v[4] = bflo(raw[p].z); v[5] = bfhi(raw[p].z); v[6] = bflo(raw[p].w); v[7] = bfhi(raw[p].w);
#pragma unroll
        for (int e = 0; e < 4; ++e) { v[e] = (v[e] - mu) * rstd * g0[e] + b0[e]; v[4 + e] = (v[4 + e] - mu) * rstd * g1[e] + b1[e]; }
        v4u o; o.x = pk2(v[0], v[1]); o.y = pk2(v[2], v[3]); o.z = pk2(v[4], v[5]); o.w = pk2(v[6], v[7]);
        *(LAS v4u*)(VN + (r0 + 32 * p) * V_STRIDE + c * 16) = o;
    }
    __syncthreads();
    f32x4 acc[8];
#pragma unroll
    for (int ct = 0; ct < 8; ++ct) {
        acc[ct] = (f32x4){0.f, 0.f, 0.f, 0.f};
#pragma unroll
        for (int s = 0; s < 4; ++s) {
            const LAS unsigned char* p0 = VN + (32 * s + 8 * fq + (fr >> 2)) * V_STRIDE + (16 * ct + 4 * (fr & 3)) * 2;
            const bf16x8 vf = tr_frag(p0, p0 + 4 * V_STRIDE);
            acc[ct] = __builtin_amdgcn_mfma_f32_16x16x32_bf16(vf, wf[s], acc[ct], 0, 0, 0);
        }
    }
    float ss = 0.f;
#pragma unroll
    for (int ct = 0; ct < 8; ++ct) {
        const float o0 = bflo(uw[ct].x) * (acc[ct][0] + bsp), o1 = bfhi(uw[ct].x) * (acc[ct][1] + bsp), o2 = bflo(uw[ct].y) * (acc[ct][2] + bsp), o3 = bfhi(uw[ct].y) * (acc[ct][3] + bsp);
        ss += (o0 * o0 + o1 * o1) + (o2 * o2 + o3 * o3);
        v2u w; w.x = pk2(o0, o1); w.y = pk2(o2, o3); *(v2u*)(orow + 16 * ct) = w;
    }
    ss += __shfl_xor(ss, 16); ss += __shfl_xor(ss, 32);
    if (fq == 0) unsafeAtomicAdd(ssmix + (size_t)tok * 2 + 1, ss);
}

__device__ __forceinline__ void convert_out_down(const Args& A, LAS unsigned char* lds, int vcu, int G) {
    int tid = threadIdx.x; asm volatile("" : "+v"(tid)); const int lane = tid & 63, wave = __builtin_amdgcn_readfirstlane(tid >> 6);
    unsigned char* ws = A.ws;
    __syncthreads();
    LAS float* scr = (LAS float*)(lds + wave * 16640);
    constexpr int I_OUT0 = (D / 64) * (D / 64), I_DN0 = (FF / 64) * (D / 64);
    for (int it = vcu * NW + wave; it < I_OUT0 + I_DN0; it += G * NW) {
        if (it < I_OUT0) transpose_tile(A.w_out, D, D, (bf16*)(ws + WS_WOUT), A.g_ao, A.g_go, 1024, scr, it, lane);
        else transpose_tile(A.w_down, FF, D, (bf16*)(ws + WS_WDOWN), nullptr, nullptr, 0, scr, it - I_OUT0, lane);
    }
    __syncthreads();
}

template <int HF> __device__ __forceinline__ void ffn_half(const Args& A, LAS unsigned char* lds, int G, int bx, const XcdBarrier& xb, bool hwx, int team) {
    unsigned char* ws = A.ws;
    bf16* HID = (bf16*)(ws + WS_HID);
    {
        pg8::Gemm g{(const bf16*)(ws + WS_XB) + (size_t)HF * TH * D, (const bf16*)(ws + WS_WUP), TH, FF, D, D}; pg8::StaticOrder S; S.init(TH, FF, G, bx, 4);
        pg8::EpiUp E{HID, (const float*)(ws + WS_SS2) + HF * TH};
        pg8::gemm_phase<pg8::EpiUp, pg8::StaticOrder, true, true>(lds, g, S, E);
    }
    if (hwx) xcd_local_barrier(xb, team, 8u); else xcd_barrier(xb);
    {
        pg8::Gemm g{HID, (const bf16*)(ws + WS_WDOWN), TH, D, FF, FF}; pg8::StaticOrder S; S.init(TH, D, G, bx, 4);
        pg8::EpiDown E{A.out + (size_t)HF * TH * D, (const bf16*)(ws + WS_XB) + (size_t)HF * TH * D};
        pg8::gemm_phase<pg8::EpiDown, pg8::StaticOrder, true, true>(lds, g, S, E);
    }
}

__global__ void __launch_bounds__(NT, 2) fwd_mega(Args A) {
    extern __shared__ __attribute__((aligned(16))) unsigned char lds_raw[];
    LAS unsigned char* lds = (LAS unsigned char*)lds_raw;
    cg::grid_group grid = cg::this_grid();
    const int tid = threadIdx.x, lane = tid & 63, wave = __builtin_amdgcn_readfirstlane(tid >> 6);
    const int G = gridDim.x, bx = blockIdx.x;
    const int vcu = (G % 8 == 0) ? (bx % 8) * (G / 8) + bx / 8 : bx;
    unsigned char* ws = A.ws;
    bf16* WinT = (bf16*)(ws + WS_WIN); bf16* WoutT = (bf16*)(ws + WS_WOUT); bf16* WupT = (bf16*)(ws + WS_WUP); bf16* WdownT = (bf16*)(ws + WS_WDOWN);
    bf16* XB = (bf16*)(ws + WS_XB); bf16* HID = (bf16*)(ws + WS_HID); bf16* MIX = (bf16*)(ws + WS_MIX);
    float* lnstat = (float*)(ws + WS_LNSTAT); float* ss2 = (float*)(ws + WS_SS2); float* r1 = (float*)(ws + WS_R1); float* ssmix = (float*)(ws + WS_SSMIX);
    bf16* PROJ = (bf16*)A.out;
    if (tid < 2) ((LAS unsigned*)(lds + LDS_BARST))[tid] = 0u;
    unsigned* barw = (unsigned*)(ws + WS_BAR);
    if (bx == 0) for (int i = tid; i < XCD_BAR_WORDS_ALL; i += NT) barw[i] = 0u;
    grid.sync();
    XcdBarrier xbar; xbar.bar = barw; xbar.x = xb_xcc_id(); xbar.st = (volatile LAS unsigned*)(lds + LDS_BARST);
    if (tid == 0) ((LAS unsigned*)(lds + LDS_BARST))[2] = xb_add(&barw[XB_XCNT(xbar.x)], 1u);

    {
        const int gw = vcu * NW + wave, NGW = G * NW;
        LAS float* scr = (LAS float*)(lds + wave * 16640);
        constexpr int I_IN = (D / 64) * (INW / 64);
        for (int it = gw; it < I_IN; it += NGW) transpose_tile(A.w_in, D, INW, WinT, A.g_mix, A.g_mix, D, scr, it, lane);
        for (int m = gw; m < T; m += NGW) {
            const float* xrow = (m < 8192) ? A.xp + (size_t)m * D : A.xs + (size_t)(m - 8192) * D;
            const f32x4* xr = (const f32x4*)xrow + lane; f32x4 v[8]; float s = 0.f;
#pragma unroll
            for (int j = 0; j < 8; ++j) { v[j] = __builtin_nontemporal_load(xr + 64 * j); s += (v[j][0] * v[j][0] + v[j][1] * v[j][1]) + (v[j][2] * v[j][2] + v[j][3] * v[j][3]); }
            s = wave_sum(s);
            if (lane == 0) r1[m] = 1.0f / sqrtf(s * (1.0f / D) + pg8::EPSN);
            v2u* o8 = (v2u*)(XB + (size_t)m * D) + lane;
#pragma unroll
            for (int j = 0; j < 8; ++j) { v2u w; w.x = pk2(v[j][0], v[j][1]); w.y = pk2(v[j][2], v[j][3]); o8[64 * j] = w; }
        }
        const int gt = vcu * NT + tid, NGT = G * NT;
        for (int i = gt; i < 8 * 128 * 128; i += NGT) ((bf16*)(ws + WS_WSP))[i] = (bf16)f2bf(A.w_sp[i]);
        for (int i = gt; i < 4096 * 16; i += NGT) {
            const int pos = i >> 4, k = i & 15;
            const float inv_freq = __builtin_amdgcn_exp2f(-(float)k * (18.931568569324174f / 16.0f));
            const float ang = (float)pos * inv_freq, rev = ang * 0.15915494309189535f, fr = rev - floorf(rev);
            float* tp = (float*)(ws + WS_TAB) + 2 * (size_t)i; tp[0] = __builtin_amdgcn_cosf(fr); tp[1] = __builtin_amdgcn_sinf(fr);
        }
        for (int i = gt; i < PAR_N; i += NGT) {
            float v = 0.f;
            if (i < PAR_GK) v = A.g_q[i]; else if (i < PAR_SINK) v = A.g_k[i - PAR_GK]; else if (i < PAR_SINK + 8) v = A.sink[i - PAR_SINK];
            else if (i < PAR_GV) v = 0.f; else if (i < PAR_BV) v = A.g_v_ln[i - PAR_GV]; else if (i < PAR_BSP) v = A.b_v_ln[i - PAR_BV]; else v = A.b_sp[i - PAR_BSP];
            ((float*)(ws + WS_PAR))[i] = v;
        }
        for (int i = gt; i < 2 * T; i += NGT) { lnstat[i] = 0.f; ssmix[i] = 0.f; }
        for (int i = gt; i < T; i += NGT) ss2[i] = 0.f;
    }
    xcd_barrier(xbar);
    if (tid == 0) {
        bool ok = (G % 8 == 0);
        for (unsigned j = 0; j < 16; ++j) { const unsigned cj = xb_ld(&barw[XB_XCNT(j)]); ok = ok && ((j < 8) ? (cj == (unsigned)(G / 8)) : (cj == 0u)); }
        LAS unsigned* st = (LAS unsigned*)(lds + LDS_BARST); st[3] = ok ? (st[2] * 8u + xbar.x) : (unsigned)bx; st[4] = ok ? 1u : 0u;
    }
    __syncthreads();
    const int cid = __builtin_amdgcn_readfirstlane((int)((LAS unsigned*)(lds + LDS_BARST))[3]);
    const int vcu2 = (G % 8 == 0) ? (cid % 8) * (G / 8) + cid / 8 : cid;
    const bool hwx = __builtin_amdgcn_readfirstlane((int)((LAS unsigned*)(lds + LDS_BARST))[4]) != 0;
    {
        pg8::Gemm g{XB, WinT, T, INW, D, D}; pg8::StaticOrder S; S.init(T, INW, G, cid, 4);
        pg8::EpiProj E{PROJ, r1, lnstat, (const float*)(ws + WS_PAR) + PAR_GQ, (const float*)(ws + WS_PAR) + PAR_GK, (const float*)(ws + WS_TAB), (LAS float*)(lds + 131072)};
        pg8::gemm_phase<pg8::EpiProj, pg8::StaticOrder, true, true>(lds, g, S, E);
        constexpr int NU = (T / 256) * (INW / 256);
        const int rem = NU % G, NH = (rem == 0) ? G : G - rem, hi = (rem == 0) ? cid : cid - rem;
        if (hi >= 0) {
            constexpr int I_UP = (D / 64) * (FF / 64);
            LAS float* scr = (LAS float*)(lds + wave * 16640);
            for (int it = hi * NW + wave; it < I_UP; it += NH * NW) transpose_tile(A.w_up, D, FF, WupT, A.g_ffn, A.g_ffn, D, scr, it, lane);
        }
    }
    xcd_barrier(xbar);
    if (!(vcu2 & 1)) convert_out_down(A, lds, vcu2, G);
#pragma unroll 1
    for (int u = vcu2; u < 1536; u += G) {
        if (u < 512) attn_unit(PROJ, ws, lds, u);
        else gmlp_unit(PROJ, ws, lds, u - 512);
    }
    if (vcu2 & 1) convert_out_down(A, lds, vcu2, G);
    xcd_barrier(xbar);
    {
        pg8::Gemm g{MIX, WoutT, T, D, D, D}; pg8::StaticOrder S; S.init(T, D, G, cid, 4, true);
        LAS pg8::f32x2* sct = (LAS pg8::f32x2*)(lds + 131072);
        for (int e = tid; e < 7 * 256; e += NT) {
            pg8::Unit u; if (!S.next(e >> 8, u)) break;
            const pg8::f32x2 p = *(const pg8::f32x2*)(ssmix + (size_t)(u.pm * 256 + (e & 255)) * 2);
            const float va = p[0] * (1.0f / 1024.0f) + pg8::EPSN, vg = p[1] * (1.0f / 1024.0f) + pg8::EPSN;
            pg8::f32x2 o; o[1] = __builtin_amdgcn_rsqf(vg); o[0] = __builtin_amdgcn_rsqf(va) * __builtin_amdgcn_sqrtf(vg); sct[e] = o;
        }
        __syncthreads();
        pg8::EpiOut E{XB, ss2, sct};
        pg8::gemm_phase<pg8::EpiOut, pg8::StaticOrder, true, true>(lds, g, S, E);
    }
    const int team = (G == 256) ? (cid >> 3) & 3 : -1;
    if (hwx) xcd_local_barrier(xbar, team, 8u); else xcd_barrier(xbar);
    ffn_half<0>(A, lds, G, cid, xbar, hwx, team);
    if (hwx) xcd_local_barrier(xbar, team, 8u); else xcd_barrier(xbar);
    ffn_half<1>(A, lds, G, cid, xbar, hwx, team);
}

extern "C" void kernel_launch(void* const* d_in, const int* in_sizes, int n_in, void* d_out, int out_size, void* d_ws, size_t ws_size, hipStream_t stream) {
    static int grid = 0;
    if (grid == 0) {
        if (n_in != 17 || out_size != T * D || ws_size < WS_END) { fprintf(stderr, "kernel_launch: unexpected sizes n_in %d out %d ws %zu (need %zu)\n", n_in, out_size, ws_size, (size_t)WS_END); }
        int dev = 0, cus = 0, per_cu = 0;
        (void)hipGetDevice(&dev); (void)hipDeviceGetAttribute(&cus, hipDeviceAttributeMultiprocessorCount, dev);
        if (hipFuncSetAttribute((const void*)fwd_mega, hipFuncAttributeMaxDynamicSharedMemorySize, LDS_BYTES) != hipSuccess) fprintf(stderr, "kernel_launch: hipFuncSetAttribute failed\n");
        if (hipOccupancyMaxActiveBlocksPerMultiprocessor(&per_cu, (const void*)fwd_mega, NT, LDS_BYTES) != hipSuccess || per_cu < 1) { fprintf(stderr, "kernel_launch: occupancy query gave %d\n", per_cu); per_cu = 1; }
        (void)hipGetLastError();
        if (cus <= 0) cus = 256;
        grid = cus * per_cu;
        fprintf(stderr, "kernel_launch: grid %d (cus %d per_cu %d) ws %zu\n", grid, cus, per_cu, ws_size);
    }
    Args a{};
    a.xp = (const float*)d_in[0]; a.xs = (const float*)d_in[1]; a.g_mix = (const float*)d_in[2]; a.w_in = (const float*)d_in[3]; a.g_q = (const float*)d_in[4]; a.g_k = (const float*)d_in[5];
    a.sink = (const float*)d_in[6]; a.g_v_ln = (const float*)d_in[7]; a.b_v_ln = (const float*)d_in[8]; a.w_sp = (const float*)d_in[9]; a.b_sp = (const float*)d_in[10];
    a.g_ao = (const float*)d_in[11]; a.g_go = (const float*)d_in[12]; a.w_out = (const float*)d_in[13]; a.g_ffn = (const float*)d_in[14]; a.w_up = (const float*)d_in[15]; a.w_down = (const float*)d_in[16];
    a.out = (float*)d_out; a.ws = (unsigned char*)d_ws;
    void* args[] = {&a};
    hipError_t e = hipLaunchCooperativeKernel((const void*)fwd_mega, dim3(grid), dim3(NT), args, LDS_BYTES, stream);
    if (e != hipSuccess) fprintf(stderr, "kernel_launch: cooperative launch failed: %s (grid %d)\n", hipGetErrorString(e), grid);
}
```
